# Optimizing an MI355X kernel written in HIP

```python
import jax
import jax.numpy as jnp
from jax import lax
import numpy as np

D_MODEL = 1024
BATCH = 8
SEQ = 4096
DEPTH = 1

GRID_W = 64
CTX_LEN = 256
EPS = 1e-6
MLA_HEADS = 8
MLA_NOPE = 64
MLA_ROPE = 32
MLA_V_HEAD = 64
MLA_Q_LORA = 384
MLA_KV_LORA = 256
MLA_WIDTH = MLA_HEADS * MLA_V_HEAD
MLA_SCALE = (MLA_NOPE + MLA_ROPE) ** -0.5
ROPE_AXIS_DIM = MLA_ROPE // 2
ROPE_THETA = 10000.0
Q_BLOCK = 128
GLA_HEADS = 4
GLA_HEAD_K = 128
GLA_HEAD_V = 128
GLA_KEY = GLA_HEADS * GLA_HEAD_K
GLA_VALUE = GLA_HEADS * GLA_HEAD_V
GLA_QSCALE = GLA_HEAD_K ** -0.5
GATE_RANK = 16
GATE_NORM = 16.0
GLA_CHUNK = 64
D_FF = 2816
CONV_W = 3
IN_SPLITS = (MLA_Q_LORA, MLA_KV_LORA, MLA_ROPE, GLA_KEY, GLA_KEY, GLA_VALUE, GLA_VALUE, 2 * GATE_RANK, 2 * D_MODEL)
IN_COLS = sum(IN_SPLITS)

kernel_name = "hybrid_mla_gla_convglu_dit"


def rms_norm(x, g):
    xf = x.astype(jnp.float32)
    y = xf * lax.rsqrt(jnp.mean(xf * xf, axis=-1, keepdims=True) + EPS)
    return (y * g.astype(jnp.float32)).astype(x.dtype)


def modulate(h, shift, scale):
    return h * (1 + scale) + shift


def split_columns(z):
    offsets = [int(o) for o in np.cumsum(IN_SPLITS)[:-1]]
    return jnp.split(z, offsets, axis=-1)


def heads(z, n_heads):
    return z.reshape(z.shape[:-1] + (n_heads, z.shape[-1] // n_heads))


def axial_angles(length):
    t = jnp.arange(length, dtype=jnp.int32)
    row = (t // GRID_W).astype(jnp.float32)
    col = (t % GRID_W).astype(jnp.float32)
    inv_freq = ROPE_THETA ** (-jnp.arange(0, ROPE_AXIS_DIM, 2, dtype=jnp.float32) / ROPE_AXIS_DIM)
    return row[:, None] * inv_freq, col[:, None] * inv_freq


def rotate_axis(x, ang):
    x1, x2 = jnp.split(x, 2, axis=-1)
    cos, sin = jnp.cos(ang), jnp.sin(ang)
    return jnp.concatenate([x1 * cos - x2 * sin, x2 * cos + x1 * sin], axis=-1)


def rope_2d(x, ang_row, ang_col):
    xf = x.astype(jnp.float32)
    xr, xc = xf[..., :ROPE_AXIS_DIM], xf[..., ROPE_AXIS_DIM:]
    return jnp.concatenate([rotate_axis(xr, ang_row), rotate_axis(xc, ang_col)], axis=-1).astype(x.dtype)


def mla_queries(q_c, q_norm_g, w_uq):
    q = heads(rms_norm(q_c, q_norm_g) @ w_uq, MLA_HEADS)
    return q[..., :MLA_NOPE], q[..., MLA_NOPE:]


def mla_keys_values(kv_c, kv_norm_g, w_ukv):
    kv = heads(rms_norm(kv_c, kv_norm_g) @ w_ukv, MLA_HEADS)
    return kv[..., :MLA_NOPE], kv[..., MLA_NOPE:]


def attention(q_nope, q_rope, k_nope, k_rope, v):
    b, lq = q_nope.shape[:2]
    nb = lq // Q_BLOCK

    def blocks(z):
        return jnp.moveaxis(z.reshape((b, nb, Q_BLOCK) + z.shape[2:]), 1, 0)

    def one_block(qs):
        qn, qr = qs
        s = jnp.einsum('bqhd,bkhd->bhqk', qn, k_nope) + jnp.einsum('bqhr,bkr->bhqk', qr, k_rope)
        p = jax.nn.softmax(s.astype(jnp.float32) * MLA_SCALE, axis=-1).astype(v.dtype)
        return jnp.einsum('bhqk,bkhd->bqhd', p, v)

    o = lax.map(one_block, (blocks(q_nope), blocks(q_rope)))
    return jnp.moveaxis(o, 0, 1).reshape(b, lq, MLA_WIDTH)


def to_chunks(z):
    b, l, h, d = z.shape
    return z.reshape(b, l // GLA_CHUNK, GLA_CHUNK, h, d).transpose(0, 3, 1, 2, 4)


def from_chunks(z):
    b, h, n, c, d = z.shape
    return z.transpose(0, 2, 3, 1, 4).reshape(b, n * c, h, d)


def chunk_state_terms(kc, vc, b_cum):
    b_last = b_cum[..., -1:, :]
    u = jnp.einsum('bhncd,bhncv->bhndv', kc * jnp.exp(b_last - b_cum), vc)
    decay = jnp.exp(b_last[..., 0, :])
    return decay, u


def scan_states(decay, u, s0):
    def step(s, inp):
        d, du = inp
        return d[..., None] * s + du, s

    s_final, s_in = lax.scan(step, s0, (jnp.moveaxis(decay, 2, 0), jnp.moveaxis(u, 2, 0)))
    return s_final, jnp.moveaxis(s_in, 0, 2)


def gla_direction(q, k, v, g, s0):
    qc, kc, vc = (to_chunks(z.astype(jnp.float32)) for z in (q, k, v))
    b_cum = jnp.cumsum(to_chunks(g), axis=3)
    decay, u = chunk_state_terms(kc, vc, b_cum)
    s_final, s_in = scan_states(decay, u, s0)
    qe = qc * jnp.exp(b_cum)
    mask = jnp.tril(jnp.ones((GLA_CHUNK, GLA_CHUNK), jnp.float32))
    a = jnp.einsum('bhncd,bhnsd->bhncs', qe, kc * jnp.exp(-b_cum)) * mask
    o = jnp.einsum('bhncs,bhnsv->bhncv', a, vc) + jnp.einsum('bhncd,bhndv->bhncv', qe, s_in)
    return from_chunks(o), s_final


def gla_final_state(k, v, g, s0):
    kc, vc = to_chunks(k.astype(jnp.float32)), to_chunks(v.astype(jnp.float32))
    decay, u = chunk_state_terms(kc, vc, jnp.cumsum(to_chunks(g), axis=3))
    s_final, _ = scan_states(decay, u, s0)
    return s_final


def flip(z):
    return jnp.flip(z, axis=1)


def gla_bidirectional(q, k, v, g_f, g_b, s_f, s_b):
    o_f, s_f_out = gla_direction(q, k, v, g_f, s_f)
    o_b, s_b_out = gla_direction(flip(q), flip(k), flip(v), flip(g_b), s_b)
    return o_f + flip(o_b), s_f_out, s_b_out


def gla_inputs(gq, gk, gv, glow, w_decay, b_decay):
    lf, lb = glow[..., :GATE_RANK], glow[..., GATE_RANK:]
    g_f = jax.nn.log_sigmoid((lf @ w_decay[0] + b_decay[0]).astype(jnp.float32)) / GATE_NORM
    g_b = jax.nn.log_sigmoid((lb @ w_decay[1] + b_decay[1]).astype(jnp.float32)) / GATE_NORM
    return (heads(gq, GLA_HEADS) * GLA_QSCALE, heads(gk, GLA_HEADS), heads(gv, GLA_HEADS),
            heads(g_f, GLA_HEADS), heads(g_b, GLA_HEADS))


def gla_branch(o, r, norm_g, w_br):
    y = rms_norm(o, norm_g).reshape(o.shape[0], o.shape[1], GLA_VALUE).astype(r.dtype) * jax.nn.silu(r)
    return y @ w_br


def merge_branches(br_mla, br_gla, gate_logits, w_out):
    g = jax.nn.sigmoid(gate_logits.astype(jnp.float32)).astype(br_mla.dtype)
    g_mla, g_gla = jnp.split(g, 2, axis=-1)
    return (g_mla * br_mla + g_gla * br_gla) @ w_out


def token_mixer(h, hc, w_in, q_norm_g, w_uq, kv_norm_g, w_ukv, w_decay, b_decay, gla_norm_g,
                w_br_mla, w_br_gla, w_out, ang_row, ang_col, update_ctx):
    q_c, kv_c, k_rope, gq, gk, gv, gr, glow, gate_logits = split_columns(h @ w_in)
    q_cc, kv_cc, k_rope_c, gq_c, gk_c, gv_c, gr_c, glow_c, gate_logits_c = split_columns(hc @ w_in)

    k_nope_c, v_c = mla_keys_values(kv_cc, kv_norm_g, w_ukv)
    k_nope, v = mla_keys_values(kv_c, kv_norm_g, w_ukv)
    q_nope, q_rope = mla_queries(q_c, q_norm_g, w_uq)
    q_rope = rope_2d(q_rope, ang_row[:, None, :], ang_col[:, None, :])
    k_rope = rope_2d(k_rope, ang_row, ang_col)
    o_mla = attention(q_nope, q_rope,
                      jnp.concatenate([k_nope, k_nope_c], axis=1),
                      jnp.concatenate([k_rope, k_rope_c], axis=1),
                      jnp.concatenate([v, v_c], axis=1))

    b = h.shape[0]
    s0 = jnp.zeros((b, GLA_HEADS, GLA_HEAD_K, GLA_HEAD_V), jnp.float32)
    qg_c, kg_c, vg_c, gf_c, gb_c = gla_inputs(gq_c, gk_c, gv_c, glow_c, w_decay, b_decay)
    qg, kg, vg, gf, gb = gla_inputs(gq, gk, gv, glow, w_decay, b_decay)
    if update_ctx:
        o_gla_c, s_f, s_b = gla_bidirectional(qg_c, kg_c, vg_c, gf_c, gb_c, s0, s0)
    else:
        s_f = gla_final_state(kg_c, vg_c, gf_c, s0)
        s_b = gla_final_state(flip(kg_c), flip(vg_c), flip(gb_c), s0)
    o_gla, _, _ = gla_bidirectional(qg, kg, vg, gf, gb, s_f, s_b)

    out_lat = merge_branches(o_mla @ w_br_mla, gla_branch(o_gla, gr, gla_norm_g, w_br_gla), gate_logits, w_out)
    out_ctx = None
    if update_ctx:
        q_nope_c, q_rope_c = mla_queries(q_cc, q_norm_g, w_uq)
        o_mla_c = attention(q_nope_c, q_rope_c, k_nope_c, k_rope_c, v_c)
        out_ctx = merge_branches(o_mla_c @ w_br_mla, gla_branch(o_gla_c, gr_c, gla_norm_g, w_br_gla),
                                 gate_logits_c, w_out)
    return out_lat, out_ctx


def depthwise_conv_grid(u, w, bias, rows, cols):
    b, l, ch = u.shape
    grid = u.reshape(b, rows, cols, ch)
    y = lax.conv_general_dilated(grid, w[:, :, None, :].astype(u.dtype), (1, 1), 'SAME',
                                 dimension_numbers=('NHWC', 'HWIO', 'NHWC'), feature_group_count=ch)
    return y.reshape(b, l, ch) + bias


def conv_ffn(h, w_up, conv_w, conv_b, w_down, rows, cols):
    val, gate = jnp.split(h @ w_up, 2, axis=-1)
    gate = depthwise_conv_grid(gate, conv_w, conv_b, rows, cols)
    return (jax.nn.gelu(gate, approximate=False) * val) @ w_down


def setup_inputs(seed: int = 0) -> dict:
    key = jax.random.key(seed)
    ks = jax.random.split(key, 24)
    f32 = jnp.float32

    def normal(k, shape, s=1.0):
        return s * jax.random.normal(k, shape, f32)

    def dense(k, shape, fan_in, gain=1.0):
        return normal(k, shape, gain * fan_in ** -0.5)

    def norm_gain(k, shape):
        return 1.0 + normal(k, shape, 0.05)

    return {
        "x": normal(ks[0], (BATCH, SEQ, D_MODEL)),
        "c": normal(ks[1], (BATCH, D_MODEL)),
        "ctx": normal(ks[2], (BATCH, CTX_LEN, D_MODEL)),
        "c_ctx": normal(ks[3], (D_MODEL,)),
        "w_ada": dense(ks[4], (DEPTH, D_MODEL, 6 * D_MODEL), D_MODEL, 0.5),
        "b_ada": normal(ks[5], (DEPTH, 6 * D_MODEL), 0.01),
        "norm1_g": norm_gain(ks[6], (DEPTH, D_MODEL)),
        "w_in": dense(ks[7], (DEPTH, D_MODEL, IN_COLS), D_MODEL),
        "q_norm_g": norm_gain(ks[8], (DEPTH, MLA_Q_LORA)),
        "w_uq": dense(ks[9], (DEPTH, MLA_Q_LORA, MLA_HEADS * (MLA_NOPE + MLA_ROPE)), MLA_Q_LORA),
        "kv_norm_g": norm_gain(ks[10], (DEPTH, MLA_KV_LORA)),
        "w_ukv": dense(ks[11], (DEPTH, MLA_KV_LORA, MLA_HEADS * (MLA_NOPE + MLA_V_HEAD)), MLA_KV_LORA),
        "gla_w_decay": dense(ks[12], (DEPTH, 2, GATE_RANK, GLA_KEY), GATE_RANK),
        "gla_b_decay": normal(ks[13], (DEPTH, 2, GLA_KEY), 0.1),
        "gla_norm_g": norm_gain(ks[14], (DEPTH, GLA_HEAD_V)),
        "w_br_mla": dense(ks[15], (DEPTH, MLA_WIDTH, D_MODEL), MLA_WIDTH),
        "w_br_gla": dense(ks[16], (DEPTH, GLA_VALUE, D_MODEL), GLA_VALUE),
        "w_out": dense(ks[17], (DEPTH, D_MODEL, D_MODEL), D_MODEL),
        "norm2_g": norm_gain(ks[18], (DEPTH, D_MODEL)),
        "w_up": dense(ks[19], (DEPTH, D_MODEL, 2 * D_FF), D_MODEL),
        "conv_w": dense(ks[20], (DEPTH, CONV_W, CONV_W, D_FF), CONV_W * CONV_W),
        "conv_b": normal(ks[21], (DEPTH, D_FF), 0.01),
        "w_down": dense(ks[22], (DEPTH, D_FF, D_MODEL), D_FF),
        "final_g": norm_gain(ks[23], (D_MODEL,)),
    }


def reference(x, c, ctx, c_ctx, w_ada, b_ada, norm1_g, w_in, q_norm_g, w_uq, kv_norm_g, w_ukv,
              gla_w_decay, gla_b_decay, gla_norm_g, w_br_mla, w_br_gla, w_out, norm2_g, w_up,
              conv_w, conv_b, w_down, final_g):
    length = x.shape[1]
    rows = length // GRID_W
    ang_row, ang_col = axial_angles(length)
    x_lat, x_ctx = x, ctx
    for layer in range(DEPTH):
        update_ctx = layer + 1 < DEPTH
        mod = jax.nn.silu(c) @ w_ada[layer] + b_ada[layer]
        mod_c = jax.nn.silu(c_ctx) @ w_ada[layer] + b_ada[layer]
        sh1, sc1, gt1, sh2, sc2, gt2 = jnp.split(mod[:, None, :], 6, axis=-1)
        sh1c, sc1c, gt1c, sh2c, sc2c, gt2c = jnp.split(mod_c, 6, axis=-1)

        h = modulate(rms_norm(x_lat, norm1_g[layer]), sh1, sc1)
        hc = modulate(rms_norm(x_ctx, norm1_g[layer]), sh1c, sc1c)
        mix, mix_c = token_mixer(h, hc, w_in[layer], q_norm_g[layer], w_uq[layer], kv_norm_g[layer],
                                 w_ukv[layer], gla_w_decay[layer], gla_b_decay[layer], gla_norm_g[layer],
                                 w_br_mla[layer], w_br_gla[layer], w_out[layer], ang_row, ang_col, update_ctx)
        x_lat = x_lat + gt1 * mix
        h = modulate(rms_norm(x_lat, norm2_g[layer]), sh2, sc2)
        x_lat = x_lat + gt2 * conv_ffn(h, w_up[layer], conv_w[layer], conv_b[layer], w_down[layer], rows, GRID_W)
        if update_ctx:
            x_ctx = x_ctx + gt1c * mix_c
            hc = modulate(rms_norm(x_ctx, norm2_g[layer]), sh2c, sc2c)
            x_ctx = x_ctx + gt2c * conv_ffn(hc, w_up[layer], conv_w[layer], conv_b[layer], w_down[layer],
                                            1, x_ctx.shape[1])
    return rms_norm(x_lat, final_g)
```

```cpp
#include <hip/hip_runtime.h>
#include <hip/hip_cooperative_groups.h>
#include <cstdio>
#include <cstdint>
namespace cg = cooperative_groups;
namespace pg8 {
#define PG8_LAS __attribute__((address_space(3)))
typedef unsigned short bf16_t;
typedef short bf16x8 __attribute__((ext_vector_type(8)));
typedef float f32x4 __attribute__((ext_vector_type(4)));
typedef unsigned u32x4 __attribute__((ext_vector_type(4)));
constexpr int BM = 256, BK = 64, HALF = 128, HTB = HALF * BK * 2  , STAGE_BYTES = 8 * HTB, NXCD = 8, WGM = 8;

__host__ __device__ __forceinline__ int lds_byte(int r, int c) { const int st = (r >> 4) * 2 + (c >> 5), rr = r & 15, cc = c & 31, ob = rr * 64 + cc * 2; return st * 1024 + (ob ^ (((ob >> 9) & 1) << 5)); }
__host__ __device__ __forceinline__ void stage_rc(int b, int& R, int& C) { const int st = b / 1024, sb = b % 1024, swz = sb ^ (((sb >> 9) & 1) << 5); R = (st >> 1) * 16 + swz / 64; C = (st & 1) * 32 + (swz % 64) / 2; }
__host__ __device__ __forceinline__ int perm32(int rho) { const int n = rho >> 4, i = rho & 15; return 8 * (i >> 2) + 4 * n + (i & 3); }

struct Unit { int pm, pn; };
struct Gemm { const bf16_t* A; const bf16_t* Bt; int M, N, K, lda; };

struct StaticOrder {
    int nM, nN, nwg, G, c;
    __host__ __device__ void init(int M, int N, int G_, int c_) { nM = M / BM; nN = N / BM; nwg = nM * nN; G = G_; c = c_; }
    __host__ __device__ bool next(int i, Unit& u) const {
        const long L = (long)i * G + c; if (L >= nwg) return false;
        int wgid = (int)L; { const int q = nwg / NXCD, r = nwg % NXCD, xcd = wgid % NXCD, off = wgid / NXCD; wgid = (xcd < r ? xcd * (q + 1) : r * (q + 1) + (xcd - r) * q) + off; }
        const int nig = WGM * nN, gid = wgid / nig, fm = gid * WGM, gsz = (nM - fm) < WGM ? (nM - fm) : WGM;
        u.pm = fm + ((wgid % nig) % gsz); u.pn = (wgid % nig) / gsz; return true;
    }
    __device__ __forceinline__ void a_ready(const Unit&) const {}
    __device__ __forceinline__ void done(const Unit&) const {}
};


template <class Epi, class Sched, bool ALIGN_EPI = false, bool SP2 = false>
__device__ __forceinline__ void gemm_phase(PG8_LAS unsigned char* lds, const Gemm g, const Sched& S, const Epi& E) {
    const int tid = threadIdx.x, wid = __builtin_amdgcn_readfirstlane(tid >> 6), lane = tid & 63, wr = wid >> 2, wc = wid & 3, fr = lane & 15, fq = lane >> 4;
    const int K = g.K, nt = K / BK;
    unsigned voffA[2], voffB[2];
#pragma unroll
    for (int i = 0; i < 2; ++i) { int R, C; stage_rc(tid * 16 + i * 8192, R, C); const int Rb = Epi::PERM ? ((R & ~31) + perm32(R & 31)) : R;
        voffA[i] = (unsigned)(R * g.lda + C) * 2u; voffB[i] = (unsigned)(Rb * K + C) * 2u; }
    const size_t kstep = (size_t)(BK * 2);
    const size_t hstep = (size_t)HALF * K * 2;
    const size_t tstep = 2 * hstep; const size_t hstepA = (size_t)HALF * g.lda * 2, tstepA = 2 * hstepA;
    const unsigned ldsw = (unsigned)wid * 1024u;
    const int aoff = lds_byte(wr * 64 + fr, fq * 8), boff = lds_byte(wc * 32 + fr, fq * 8);
#define PG8_SA(b, h) (((b) * 2 + (h)) * HTB)
#define PG8_SB(b, h) ((4 + (b) * 2 + (h)) * HTB)
#define PG8_STAGE(bufoff, gbase, voff) do { _Pragma("unroll") for (int _i = 0; _i < 2; ++_i) \
        __builtin_amdgcn_global_load_lds((const unsigned*)((const char*)(gbase) + (voff)[_i]), (PG8_LAS unsigned*)(lds + (bufoff) + ldsw + _i * 8192), 16, 0, 0); } while (0)
#define PG8_LDA(dst, b, h) do { _Pragma("unroll") for (int m = 0; m < 4; ++m) _Pragma("unroll") for (int k = 0; k < 2; ++k) dst[m][k] = *(const PG8_LAS bf16x8*)(lds + PG8_SA(b, h) + aoff + m * 2048 + k * 1024); } while (0)
#define PG8_LDB(dst, b, h) do { _Pragma("unroll") for (int n = 0; n < 2; ++n) _Pragma("unroll") for (int k = 0; k < 2; ++k) dst[n][k] = *(const PG8_LAS bf16x8*)(lds + PG8_SB(b, h) + boff + n * 2048 + k * 1024); } while (0)
#define PG8_MMA(ai, bj, At, Bt) do { __builtin_amdgcn_s_setprio(1); _Pragma("unroll") for (int m = 0; m < 4; ++m) _Pragma("unroll") for (int n = 0; n < 2; ++n) _Pragma("unroll") for (int k = 0; k < 2; ++k) \
        acc[ai][bj][m][n] = __builtin_amdgcn_mfma_f32_16x16x32_bf16(Bt[n][k], At[m][k], acc[ai][bj][m][n], 0, 0, 0); __builtin_amdgcn_s_setprio(0); } while (0)
#define PG8_WAIT_V(n) asm volatile("s_waitcnt vmcnt(" #n ")" ::: "memory")
#define PG8_WAIT_L(n) asm volatile("s_waitcnt lgkmcnt(" #n ")" ::: "memory")
#define PG8_BAR __builtin_amdgcn_s_barrier()
#define PG8_SCHED __builtin_amdgcn_sched_barrier(0)
    Unit cur, nxt; int ui = 0;
    if (!S.next(0, cur)) return;
    f32x4 acc[2][2][4][2];
#pragma unroll
    for (int a = 0; a < 2; ++a)
#pragma unroll
        for (int b = 0; b < 2; ++b)
#pragma unroll
            for (int m = 0; m < 4; ++m)
#pragma unroll
                for (int n = 0; n < 2; ++n) acc[a][b][m][n] = (f32x4){0.f, 0.f, 0.f, 0.f};
    bf16x8 At[4][2], B0[2][2], B1[2][2];
    const char* cA = (const char*)g.A + (size_t)cur.pm * tstepA; const char* cB = (const char*)g.Bt + (size_t)cur.pn * tstep;
    S.a_ready(cur);
    if constexpr (SP2) {
        PG8_STAGE(PG8_SB(0, 0), cB, voffB); PG8_STAGE(PG8_SB(0, 1), cB + hstep, voffB); PG8_STAGE(PG8_SA(0, 0), cA, voffA); PG8_STAGE(PG8_SA(0, 1), cA + hstepA, voffA);
        if (wr == 1) PG8_BAR;
        PG8_WAIT_V(2); PG8_BAR;
        PG8_STAGE(PG8_SB(1, 0), cB + kstep, voffB); PG8_STAGE(PG8_SA(1, 0), cA + kstep, voffA); PG8_STAGE(PG8_SB(1, 1), cB + hstep + kstep, voffB);
        PG8_WAIT_V(6); PG8_BAR;
    } else {
        PG8_STAGE(PG8_SB(0, 0), cB, voffB); PG8_STAGE(PG8_SA(0, 0), cA, voffA); PG8_STAGE(PG8_SB(0, 1), cB + hstep, voffB); PG8_STAGE(PG8_SA(0, 1), cA + hstepA, voffA);
        if (wr == 1) PG8_BAR;
        PG8_WAIT_V(4); PG8_BAR;
        PG8_STAGE(PG8_SB(1, 0), cB + kstep, voffB); PG8_STAGE(PG8_SA(1, 0), cA + kstep, voffA); PG8_STAGE(PG8_SB(1, 1), cB + hstep + kstep, voffB);
        PG8_WAIT_V(6); PG8_BAR;
    }
    for (;;) {
        const bool has_next = S.next(ui + 1, nxt);
        const char* nA = has_next ? (const char*)g.A + (size_t)nxt.pm * tstepA : cA; const char* nB = has_next ? (const char*)g.Bt + (size_t)nxt.pn * tstep : cB;
        for (int t = 0; t < nt; t += 2) {
            const bool last = (t == nt - 2);
            const char* a1 = cA + (size_t)(t + 1) * kstep;
            const char* a2 = last ? nA : cA + (size_t)(t + 2) * kstep; const char* b2 = last ? nB : cB + (size_t)(t + 2) * kstep;
            const char* a3 = a2 + kstep; const char* b3 = b2 + kstep;
            if (last && has_next) S.a_ready(nxt);
            if constexpr (SP2) {
            PG8_LDB(B0, 0, 0); PG8_LDB(B1, 0, 1); PG8_SCHED; PG8_LDA(At, 0, 0); PG8_STAGE(PG8_SA(1, 1), a1 + hstepA, voffA);
            PG8_WAIT_V(8); PG8_WAIT_L(0); PG8_BAR; PG8_MMA(0, 0, At, B0); PG8_MMA(0, 1, At, B1); PG8_BAR; PG8_SCHED;
            PG8_LDA(At, 0, 1); PG8_STAGE(PG8_SB(0, 0), b2, voffB); PG8_STAGE(PG8_SB(0, 1), b2 + hstep, voffB); PG8_STAGE(PG8_SA(0, 0), a2, voffA);
            PG8_WAIT_V(8); PG8_WAIT_L(0); PG8_BAR; PG8_MMA(1, 0, At, B0); PG8_MMA(1, 1, At, B1); PG8_BAR; PG8_SCHED;
            PG8_LDB(B0, 1, 0); PG8_LDB(B1, 1, 1); PG8_SCHED; PG8_LDA(At, 1, 0); PG8_STAGE(PG8_SA(0, 1), a2 + hstepA, voffA);
            PG8_WAIT_V(8); PG8_WAIT_L(0); PG8_BAR; PG8_MMA(0, 0, At, B0); PG8_MMA(0, 1, At, B1); PG8_BAR; PG8_SCHED;
            PG8_LDA(At, 1, 1); PG8_STAGE(PG8_SB(1, 0), b3, voffB); PG8_STAGE(PG8_SB(1, 1), b3 + hstep, voffB); PG8_STAGE(PG8_SA(1, 0), a3, voffA);
            PG8_WAIT_V(8); PG8_WAIT_L(0); PG8_BAR; PG8_MMA(1, 0, At, B0); PG8_MMA(1, 1, At, B1); PG8_BAR; PG8_SCHED;
            } else {
            PG8_LDB(B0, 0, 0); PG8_SCHED; PG8_LDA(At, 0, 0); PG8_STAGE(PG8_SA(1, 1), a1 + hstepA, voffA);
            PG8_WAIT_L(8); PG8_BAR; PG8_WAIT_L(0); PG8_MMA(0, 0, At, B0); PG8_BAR; PG8_SCHED;
            PG8_LDB(B1, 0, 1); PG8_STAGE(PG8_SB(0, 0), b2, voffB);
            PG8_BAR; PG8_WAIT_L(0); PG8_MMA(0, 1, At, B1); PG8_BAR;
            PG8_LDA(At, 0, 1); PG8_STAGE(PG8_SA(0, 0), a2, voffA);
            PG8_BAR; PG8_WAIT_L(0); PG8_MMA(1, 0, At, B0); PG8_BAR; PG8_SCHED;
            PG8_STAGE(PG8_SB(0, 1), b2 + hstep, voffB);
            PG8_WAIT_V(6); PG8_BAR; PG8_MMA(1, 1, At, B1); PG8_BAR;
            PG8_LDB(B0, 1, 0); PG8_SCHED; PG8_LDA(At, 1, 0); PG8_STAGE(PG8_SA(0, 1), a2 + hstepA, voffA);
            PG8_WAIT_L(8); PG8_BAR; PG8_WAIT_L(0); PG8_MMA(0, 0, At, B0); PG8_BAR; PG8_SCHED;
            PG8_LDB(B1, 1, 1); PG8_STAGE(PG8_SB(1, 0), b3, voffB);
            PG8_BAR; PG8_WAIT_L(0); PG8_MMA(0, 1, At, B1); PG8_BAR;
            PG8_LDA(At, 1, 1); PG8_STAGE(PG8_SA(1, 0), a3, voffA);
            PG8_BAR; PG8_WAIT_L(0); PG8_MMA(1, 0, At, B0); PG8_BAR; PG8_SCHED;
            PG8_STAGE(PG8_SB(1, 1), b3 + hstep, voffB);
            PG8_WAIT_V(6); PG8_BAR; PG8_MMA(1, 1, At, B1); PG8_BAR;
            }
        }
        if constexpr (ALIGN_EPI) { if (wr == 0) PG8_BAR; }
        if constexpr (!Epi::AFTER_DRAIN) { E(acc, cur, wr, wc, fr, fq); S.done(cur); }
        if (!has_next) break;
#pragma unroll
        for (int a = 0; a < 2; ++a)
#pragma unroll
            for (int b = 0; b < 2; ++b)
#pragma unroll
                for (int m = 0; m < 4; ++m)
#pragma unroll
                    for (int n = 0; n < 2; ++n) acc[a][b][m][n] = (f32x4){0.f, 0.f, 0.f, 0.f};
        cur = nxt; cA = nA; cB = nB; ++ui;
        if constexpr (ALIGN_EPI) { if (wr == 1) PG8_BAR; }
    }
    PG8_WAIT_V(0);
    if constexpr (!ALIGN_EPI) { if (wr == 0) PG8_BAR; }
    PG8_BAR;
    if constexpr (Epi::AFTER_DRAIN) { E.fused(acc, cur, wr, wc, fr, fq, lds, wid, lane); S.done(cur); }
#undef PG8_SA
#undef PG8_SB
#undef PG8_STAGE
#undef PG8_LDA
#undef PG8_LDB
#undef PG8_MMA
#undef PG8_WAIT_V
#undef PG8_WAIT_L
#undef PG8_BAR
#undef PG8_SCHED
}
}
#define DI __device__ __forceinline__
#define LAS __attribute__((address_space(3)))
typedef unsigned short bf16;
typedef unsigned v4u __attribute__((ext_vector_type(4)));
typedef unsigned v2u __attribute__((ext_vector_type(2)));
typedef float f32x4 __attribute__((ext_vector_type(4)));
typedef float f32x2 __attribute__((ext_vector_type(2)));
typedef short bf16x8 __attribute__((ext_vector_type(8)));
typedef short s16x4 __attribute__((ext_vector_type(4)));

constexpr int DM = 1024, NBATCH = 8, SEQ = 4096, CTX = 256;
constexpr int ML = NBATCH * SEQ, MC = NBATCH * CTX, MA = ML + MC;
constexpr int ZW = 4864;
constexpr int ZQ = 0, ZKV = 384, ZKR = 640, ZGQ = 672, ZGK = 1184, ZGV = 1696, ZGR = 2208, ZGL = 2720, ZGM = 2752, ZGG = 3776;
constexpr int LK = SEQ + CTX;
constexpr int FF = 2816, FF2 = 5632;
constexpr float EPS = 1e-6f;
constexpr float QSCALE = 0.10206207261596577f * 1.4426950408889634f;
constexpr float GLA_QSCALE = 0.08838834764831845f;
constexpr size_t MiB = 1u << 20;
constexpr size_t WS_SSQ = 0, WS_SSKV = 256 * 1024, WS_BAR = 416 * 1024, WS_SS2 = 640 * 1024, WS_ZERO_BYTES = 1 * MiB, WS_MOD = 1 * MiB, WS_BIAS2 = 1 * MiB + 256 * 1024;
constexpr size_t WS_WIN = 2 * MiB, WS_WUQ = 12 * MiB, WS_WUKV = 13 * MiB, WS_WBRM = 14 * MiB, WS_WBRG = 15 * MiB, WS_WOUT = 16 * MiB, WS_WUP = 18 * MiB, WS_WDOWN = 29 * MiB, WS_CONVW = 35 * MiB;
constexpr size_t WS_H = 36 * MiB;
constexpr size_t WS_QN = 36 * MiB, WS_QR = 68 * MiB, WS_UCTX = 84 * MiB, WS_DEC = 92 * MiB, WS_Y = 68 * MiB;
constexpr size_t WS_Z = 104 * MiB;
constexpr size_t WS_KN = 427 * MiB, WS_VT = 461 * MiB, WS_KR = 495 * MiB, WS_T1 = 427 * MiB;
constexpr size_t WS_END = 512 * MiB;

struct Args {
    const float* in[24]; float* out; unsigned char* ws; int ph_lo, ph_hi, dup, pad;
};

DI float bf2f(unsigned u) { return __builtin_bit_cast(float, u << 16); }
DI unsigned pk2(float lo, float hi);
DI unsigned f2bf(float f) { return pk2(f, 0.f) & 0xffffu; }
typedef __bf16 bf16x2_t __attribute__((ext_vector_type(2)));
DI unsigned pk2(float lo, float hi) { const f32x2 v = {lo, hi}; const bf16x2_t b = __builtin_convertvector(v, bf16x2_t); return __builtin_bit_cast(unsigned, b); }
DI float lo16(unsigned w) { return __builtin_bit_cast(float, w << 16); }
DI float hi16(unsigned w) { return __builtin_bit_cast(float, w & 0xffff0000u); }
DI float wave_sum(float v) {
#pragma unroll
    for (int o = 1; o < 64; o <<= 1) v += __shfl_xor(v, o);
    return v;
}
DI float sigmoidf_(float x) { return 1.f / (1.f + __expf(-x)); }
DI float rope_invf(int i) { return __builtin_amdgcn_exp2f(-1.6609640474436813f * (float)i); }
DI int rope_perm(int r) { const int a = r >> 4, rr = r & 15, half = rr >> 3, i = rr & 7; return 16 * a + 2 * i + half; }

DI int perm_col(int mode, int n) {
    if (mode == 1) { const int h = n / 96, w = n - 96 * h; return (w >= 64) ? h * 96 + 64 + rope_perm(w - 64) : n; }
    if (mode == 2) { return (n >= ZKR && n < ZKR + 32) ? ZKR + rope_perm(n - ZKR) : n; }
    return n;
}
DI void p0_transpose_item(const float* W, int K, int N, bf16* WT, const float* kscale, int mode, LAS float* scr, int item, int lane) {
    const int nblk = N / 32, kb = item / nblk, nb = item % nblk, k0 = 64 * kb, n0 = 32 * nb;
#pragma unroll 8
    for (int i = 0; i < 32; ++i) { const int kk = 2 * i + (lane >> 5); scr[kk * 33 + (lane & 31)] = W[(size_t)(k0 + kk) * N + n0 + (lane & 31)]; }
    asm volatile("s_waitcnt lgkmcnt(0)" ::: "memory");
    const int c = lane & 7;
    float ks[8];
#pragma unroll
    for (int i = 0; i < 8; ++i) ks[i] = kscale ? kscale[k0 + 8 * c + i] : 1.f;
#pragma unroll
    for (int j = 0; j < 4; ++j) { const int n = (lane >> 3) + 8 * j; const LAS float* s = scr + (8 * c) * 33 + n;
        v4u o; o.x = pk2(s[0 * 33] * ks[0], s[1 * 33] * ks[1]); o.y = pk2(s[2 * 33] * ks[2], s[3 * 33] * ks[3]); o.z = pk2(s[4 * 33] * ks[4], s[5 * 33] * ks[5]); o.w = pk2(s[6 * 33] * ks[6], s[7 * 33] * ks[7]);
        *(v4u*)(WT + (size_t)perm_col(mode, n0 + n) * K + k0 + 8 * c) = o; }
    asm volatile("s_waitcnt lgkmcnt(0)" ::: "memory");
}

DI void p0_mod(const Args& A, LAS float* sc, int tid, int wave, int lane, int blk) {
    const float* c = A.in[1]; const float* cctx = A.in[3]; const float* w_ada = A.in[4]; const float* b_ada = A.in[5];
    float* mod = (float*)(A.ws + WS_MOD);
    for (int i = tid; i < 9 * 1024; i += 512) { const int r = i >> 10, k = i & 1023; const float v = (r < 8) ? c[r * 1024 + k] : cctx[k]; sc[i] = v / (1.f + __expf(-v)); }
    __syncthreads();
    const int col = blk * 64 + lane;
    float acc[9];
#pragma unroll
    for (int r = 0; r < 9; ++r) acc[r] = 0.f;
    for (int k = wave * 128; k < wave * 128 + 128; ++k) { const float w = w_ada[(size_t)k * 6144 + col];
#pragma unroll
        for (int r = 0; r < 9; ++r) acc[r] += sc[r * 1024 + k] * w; }
    LAS float* red = sc + 9 * 1024;
#pragma unroll
    for (int r = 0; r < 9; ++r) red[(wave * 9 + r) * 64 + lane] = acc[r];
    __syncthreads();
    for (int i = tid; i < 9 * 64; i += 512) { const int r = i >> 6, l = i & 63; float s = b_ada[blk * 64 + l];
#pragma unroll
        for (int w = 0; w < 8; ++w) s += red[(w * 9 + r) * 64 + l];
        mod[r * 6144 + blk * 64 + l] = s; }
    __syncthreads();
}

DI void p0_transposes(const Args& A, LAS unsigned char* lds, int tid, int wave, int lane) {
    unsigned char* ws = A.ws;
    LAS float* scr = (LAS float*)(lds + wave * 16384);
    const int gw = blockIdx.x * 8 + wave, NGW = gridDim.x * 8;
    constexpr int I1 = 16 * 150, I2 = 6 * 24, I3 = 4 * 32, I4 = 8 * 32, I5 = 8 * 32, I6 = 16 * 32, I7 = 16 * 176, I8 = 44 * 32;
    constexpr int NITEMS = I1 + I2 + I3 + I4 + I5 + I6 + I7 + I8;
    for (int it = gw; it < NITEMS; it += NGW) {
        int r = it;
        if (r < I1) { p0_transpose_item(A.in[7], 1024, 4800, (bf16*)(ws + WS_WIN), nullptr, 2, scr, r, lane); continue; } r -= I1;
        if (r < I2) { p0_transpose_item(A.in[9], 384, 768, (bf16*)(ws + WS_WUQ), A.in[8], 1, scr, r, lane); continue; } r -= I2;
        if (r < I3) { p0_transpose_item(A.in[11], 256, 1024, (bf16*)(ws + WS_WUKV), A.in[10], 0, scr, r, lane); continue; } r -= I3;
        if (r < I4) { p0_transpose_item(A.in[15], 512, 1024, (bf16*)(ws + WS_WBRM), nullptr, 0, scr, r, lane); continue; } r -= I4;
        if (r < I5) { p0_transpose_item(A.in[16], 512, 1024, (bf16*)(ws + WS_WBRG), nullptr, 0, scr, r, lane); continue; } r -= I5;
        if (r < I6) { p0_transpose_item(A.in[17], 1024, 1024, (bf16*)(ws + WS_WOUT), nullptr, 0, scr, r, lane); continue; } r -= I6;
        if (r < I7) { p0_transpose_item(A.in[19], 1024, 5632, (bf16*)(ws + WS_WUP), nullptr, 0, scr, r, lane); continue; } r -= I7;
        p0_transpose_item(A.in[22], 2816, 1024, (bf16*)(ws + WS_WDOWN), nullptr, 0, scr, r, lane);
    }
    const int gt = blockIdx.x * 512 + tid, GT = gridDim.x * 512;
    for (int i = gt; i < 64 * 1024 / 8; i += GT) *(v4u*)((bf16*)(ws + WS_WIN) + (size_t)4800 * 1024 + (size_t)i * 8) = (v4u){0u, 0u, 0u, 0u};
    for (int i = gt; i < 9 * FF / 2; i += GT) ((unsigned*)(ws + WS_CONVW))[i] = pk2(A.in[20][2 * i], A.in[20][2 * i + 1]);
}

DI void rownorm_fin(const f32x4 (&v)[4], float ssum, const float* g, const float* sh, const float* sc, bf16* orow, int lane) {
    const float rstd = __builtin_amdgcn_rsqf(ssum * (1.f / 1024.f) + EPS);
    v2u* o8 = (v2u*)orow + lane;
#pragma unroll
    for (int j = 0; j < 4; ++j) {
        const f32x4 gg = ((const f32x4*)g)[lane + 64 * j], ss = ((const f32x4*)sc)[lane + 64 * j], hh = ((const f32x4*)sh)[lane + 64 * j];
        const f32x4 y = v[j] * rstd * gg * (ss + 1.f) + hh;
        v2u w; w.x = pk2(y.x, y.y); w.y = pk2(y.z, y.w); o8[64 * j] = w; }
}
DI void rownorm_mod2(const float* x0, const float* x1, const float* g, const float* sh0, const float* sc0, const float* sh1, const float* sc1, bf16* o0, bf16* o1, int lane) {
    const f32x4* xr0 = (const f32x4*)x0 + lane; const f32x4* xr1 = (const f32x4*)(x1 ? x1 : x0) + lane;
    f32x4 v0[4], v1[4]; float s0 = 0.f, s1 = 0.f;
#pragma unroll
    for (int j = 0; j < 4; ++j) { v0[j] = xr0[64 * j]; v1[j] = xr1[64 * j]; }
#pragma unroll
    for (int j = 0; j < 4; ++j) { s0 += (v0[j].x * v0[j].x + v0[j].y * v0[j].y) + (v0[j].z * v0[j].z + v0[j].w * v0[j].w); s1 += (v1[j].x * v1[j].x + v1[j].y * v1[j].y) + (v1[j].z * v1[j].z + v1[j].w * v1[j].w); }
#pragma unroll
    for (int o = 1; o < 64; o <<= 1) { s0 += __shfl_xor(s0, o); s1 += __shfl_xor(s1, o); }
    rownorm_fin(v0, s0, g, sh0, sc0, o0, lane);
    if (x1) rownorm_fin(v1, s1, g, sh1, sc1, o1, lane);
}
typedef const f32x4 (&AccRef)[2][2][4][2];
DI v4u pack8(f32x4 v0, f32x4 v1) { v4u w; w.x = pk2(v0[0], v0[1]); w.y = pk2(v0[2], v0[3]); w.z = pk2(v1[0], v1[1]); w.w = pk2(v1[2], v1[3]); return w; }

DI void epi_bf16(AccRef acc, const pg8::Unit& u, int wr, int wc, int fr, int fq, bf16* O, int ldc) {
    const int row0 = u.pm * 256 + wr * 64 + fr, col0 = u.pn * 256 + wc * 32 + 8 * fq;
#pragma unroll
    for (int ai = 0; ai < 2; ++ai)
#pragma unroll
        for (int m = 0; m < 4; ++m) { bf16* rowp = O + (size_t)(row0 + ai * 128 + m * 16) * ldc + col0;
#pragma unroll
            for (int bj = 0; bj < 2; ++bj) *(v4u*)(rowp + bj * 128) = pack8(acc[ai][bj][m][0], acc[ai][bj][m][1]); }
}
DI void epi_sumsq(AccRef acc, const pg8::Unit& u, int wr, int wc, int fr, int fq, float* ssq, float* sskv) {
    if (u.pn > 2) return;
#pragma unroll
    for (int bj = 0; bj < 2; ++bj) { const int colb = u.pn * 256 + bj * 128; float* dst = colb < 384 ? ssq : (colb < 640 ? sskv : nullptr);
        if (dst) {
#pragma unroll
            for (int ai = 0; ai < 2; ++ai)
#pragma unroll
                for (int m = 0; m < 4; ++m) { const f32x4 a = acc[ai][bj][m][0], b = acc[ai][bj][m][1];
                    float s = (a[0] * a[0] + a[1] * a[1]) + (a[2] * a[2] + a[3] * a[3]) + (b[0] * b[0] + b[1] * b[1]) + (b[2] * b[2] + b[3] * b[3]);
                    s += __shfl_xor(s, 16); s += __shfl_xor(s, 32);
                    if (fq == 0) atomicAdd(dst + (u.pm * 256 + ai * 128 + wr * 64 + m * 16 + fr), s); } } }
}
DI void epi_q(AccRef acc, const pg8::Unit& u, int wr, int wc, int fr, int fq, const float* ssq, bf16* Qn, bf16* Qr) {
#pragma unroll
    for (int ai = 0; ai < 2; ++ai)
#pragma unroll
        for (int m = 0; m < 4; ++m) { const int row = u.pm * 256 + ai * 128 + wr * 64 + m * 16 + fr;
            const float rs = __builtin_amdgcn_rsqf(ssq[row] * (1.f / 384.f) + EPS) * QSCALE; const int t = row & 4095; const float prow = (float)(t >> 6), pcol = (float)(t & 63);
#pragma unroll
            for (int bj = 0; bj < 2; ++bj)
#pragma unroll
                for (int n = 0; n < 2; ++n) { const int col4 = u.pn * 256 + bj * 128 + wc * 32 + 8 * fq + 4 * n, h = col4 / 96, w = col4 - 96 * h; const f32x4 v = acc[ai][bj][m][n] * rs;
                    if (w < 64) { v2u o; o.x = pk2(v[0], v[1]); o.y = pk2(v[2], v[3]); *(v2u*)(Qn + (size_t)row * 512 + h * 64 + w) = o; }
                    else { const int r0 = w - 64, a = r0 >> 4, i0 = (r0 & 15) >> 1; const float pos = a ? pcol : prow;
                        const float a0 = pos * rope_invf(i0), a1 = pos * rope_invf(i0 + 1); const float c0 = __cosf(a0), s0 = __sinf(a0), c1 = __cosf(a1), s1 = __sinf(a1);
                        v2u o; o.x = pk2(v[0] * c0 - v[1] * s0, v[1] * c0 + v[0] * s0); o.y = pk2(v[2] * c1 - v[3] * s1, v[3] * c1 + v[2] * s1);
                        *(v2u*)(Qr + (size_t)row * 256 + h * 32 + r0) = o; } } }
}
DI void epi_kv(AccRef acc, const pg8::Unit& u, int wr, int wc, int fr, int fq, const float* sskv, bf16* Kn, bf16* VT) {
#pragma unroll
    for (int ai = 0; ai < 2; ++ai)
#pragma unroll
        for (int m = 0; m < 4; ++m) { const int row = u.pm * 256 + ai * 128 + wr * 64 + m * 16 + fr;
            const float rs = __builtin_amdgcn_rsqf(sskv[row] * (1.f / 256.f) + EPS);
            int b, key; if (row < ML) { b = row >> 12; key = row & 4095; } else { const int r = row - ML; b = r >> 8; key = SEQ + (r & 255); }
#pragma unroll
            for (int bj = 0; bj < 2; ++bj) { const int h = u.pn * 2 + bj; const f32x4 v0 = acc[ai][bj][m][0] * rs, v1 = acc[ai][bj][m][1] * rs;
                if (wc < 2) { *(v4u*)(Kn + ((size_t)(b * 8 + h) * LK + key) * 64 + wc * 32 + 8 * fq) = pack8(v0, v1); }
                else { bf16* p = VT + ((size_t)(b * 8 + h) * 64 + (wc - 2) * 32 + 8 * fq) * LK + key;
                    p[0] = (bf16)f2bf(v0[0]); p[LK] = (bf16)f2bf(v0[1]); p[2 * LK] = (bf16)f2bf(v0[2]); p[3 * LK] = (bf16)f2bf(v0[3]);
                    p[4 * LK] = (bf16)f2bf(v1[0]); p[5 * LK] = (bf16)f2bf(v1[1]); p[6 * LK] = (bf16)f2bf(v1[2]); p[7 * LK] = (bf16)f2bf(v1[3]); } } }
}
DI void epi_t1(AccRef acc, const pg8::Unit& u, int wr, int wc, int fr, int fq, const bf16* Z, bf16* T1, bool second) {
    const int goff = second ? ZGG : ZGM;
#pragma unroll
    for (int ai = 0; ai < 2; ++ai)
#pragma unroll
        for (int m = 0; m < 4; ++m) { const int row = u.pm * 256 + ai * 128 + wr * 64 + m * 16 + fr;
#pragma unroll
            for (int bj = 0; bj < 2; ++bj) { const int col8 = u.pn * 256 + bj * 128 + wc * 32 + 8 * fq;
                const v4u g = *(const v4u*)(Z + (size_t)row * ZW + goff + col8);
                f32x4 v0 = acc[ai][bj][m][0], v1 = acc[ai][bj][m][1];
                v0[0] *= sigmoidf_(lo16(g.x)); v0[1] *= sigmoidf_(hi16(g.x)); v0[2] *= sigmoidf_(lo16(g.y)); v0[3] *= sigmoidf_(hi16(g.y));
                v1[0] *= sigmoidf_(lo16(g.z)); v1[1] *= sigmoidf_(hi16(g.z)); v1[2] *= sigmoidf_(lo16(g.w)); v1[3] *= sigmoidf_(hi16(g.w));
                bf16* dst = T1 + (size_t)row * 1024 + col8;
                if (second) { const v4u t = *(const v4u*)dst;
                    v0[0] += lo16(t.x); v0[1] += hi16(t.x); v0[2] += lo16(t.y); v0[3] += hi16(t.y); v1[0] += lo16(t.z); v1[1] += hi16(t.z); v1[2] += lo16(t.w); v1[3] += hi16(t.w); }
                *(v4u*)dst = pack8(v0, v1); } }
}
DI void epi_res(AccRef acc, const pg8::Unit& u, int wr, int wc, int fr, int fq, const float* base, const float* gate, float* dst) {
#pragma unroll
    for (int ai = 0; ai < 2; ++ai)
#pragma unroll
        for (int m = 0; m < 4; ++m) { const int row = u.pm * 256 + ai * 128 + wr * 64 + m * 16 + fr; const float* gp = gate + (size_t)(row >> 12) * 6144;
#pragma unroll
            for (int bj = 0; bj < 2; ++bj)
#pragma unroll
                for (int n = 0; n < 2; ++n) { const int col4 = u.pn * 256 + bj * 128 + wc * 32 + 8 * fq + 4 * n;
                    const f32x4 xb = *(const f32x4*)(base + (size_t)row * 1024 + col4), gg = *(const f32x4*)(gp + col4);
                    *(f32x4*)(dst + (size_t)row * 1024 + col4) = xb + gg * acc[ai][bj][m][n]; } }
}
DI void epi_x1(AccRef acc, const pg8::Unit& u, int wr, int wc, int fr, int fq, const float* x, const float* mod, float* dst, const float* g2, bf16* H2, float* ss2) {
    const float* mb = mod + (size_t)((u.pm * 256) >> 12) * 6144;
    f32x4 gt[2][2], gm[2][2];
#pragma unroll
    for (int bj = 0; bj < 2; ++bj)
#pragma unroll
        for (int n = 0; n < 2; ++n) { const int col4 = u.pn * 256 + bj * 128 + wc * 32 + 8 * fq + 4 * n;
            gt[bj][n] = *(const f32x4*)(mb + 2048 + col4); gm[bj][n] = *(const f32x4*)(g2 + col4) * (*(const f32x4*)(mb + 4096 + col4) + 1.f); }
#pragma unroll
    for (int ai = 0; ai < 2; ++ai)
#pragma unroll
        for (int m = 0; m < 4; ++m) { const int row = u.pm * 256 + ai * 128 + wr * 64 + m * 16 + fr; float ssum = 0.f;
#pragma unroll
            for (int bj = 0; bj < 2; ++bj) { const int col8 = u.pn * 256 + bj * 128 + wc * 32 + 8 * fq;
                const f32x4 x0 = *(const f32x4*)(x + (size_t)row * 1024 + col8) + gt[bj][0] * acc[ai][bj][m][0], x1 = *(const f32x4*)(x + (size_t)row * 1024 + col8 + 4) + gt[bj][1] * acc[ai][bj][m][1];
                *(f32x4*)(dst + (size_t)row * 1024 + col8) = x0; *(f32x4*)(dst + (size_t)row * 1024 + col8 + 4) = x1;
                ssum += (x0[0] * x0[0] + x0[1] * x0[1]) + (x0[2] * x0[2] + x0[3] * x0[3]) + (x1[0] * x1[0] + x1[1] * x1[1]) + (x1[2] * x1[2] + x1[3] * x1[3]);
                *(v4u*)(H2 + (size_t)row * 1024 + col8) = pack8(x0 * gm[bj][0], x1 * gm[bj][1]); }
            ssum += __shfl_xor(ssum, 16); ssum += __shfl_xor(ssum, 32);
            if (fq == 0) atomicAdd(ss2 + row, ssum); }
}
DI void epi_up(AccRef acc, const pg8::Unit& u, int wr, int wc, int fr, int fq, bf16* VG, const float* ss2, const float* bias2) {
    const float* bb = bias2 + (size_t)((u.pm * 256) >> 12) * FF2;
    f32x4 bv[2][2];
#pragma unroll
    for (int bj = 0; bj < 2; ++bj)
#pragma unroll
        for (int n = 0; n < 2; ++n) bv[bj][n] = *(const f32x4*)(bb + u.pn * 256 + bj * 128 + wc * 32 + 8 * fq + 4 * n);
#pragma unroll
    for (int ai = 0; ai < 2; ++ai)
#pragma unroll
        for (int m = 0; m < 4; ++m) { const int row = u.pm * 256 + ai * 128 + wr * 64 + m * 16 + fr; const float rs = __builtin_amdgcn_rsqf(ss2[row] * (1.f / 1024.f) + EPS);
            bf16* rowp = VG + (size_t)row * FF2 + u.pn * 256 + wc * 32 + 8 * fq;
#pragma unroll
            for (int bj = 0; bj < 2; ++bj) *(v4u*)(rowp + bj * 128) = pack8(acc[ai][bj][m][0] * rs + bv[bj][0], acc[ai][bj][m][1] * rs + bv[bj][1]); }
}
DI void bias2_phase(const Args& A, int wave, int lane) {
    const bf16* Wup = (const bf16*)(A.ws + WS_WUP); const float* mod = (const float*)(A.ws + WS_MOD); float* b2 = (float*)(A.ws + WS_BIAS2);
    for (int n = blockIdx.x * 8 + wave; n < FF2; n += gridDim.x * 8) {
        const v4u w0 = *(const v4u*)(Wup + (size_t)n * 1024 + lane * 16), w1 = *(const v4u*)(Wup + (size_t)n * 1024 + lane * 16 + 8);
        const f32x4 wa = {lo16(w0.x), hi16(w0.x), lo16(w0.y), hi16(w0.y)}, wb = {lo16(w0.z), hi16(w0.z), lo16(w0.w), hi16(w0.w)}, wc_ = {lo16(w1.x), hi16(w1.x), lo16(w1.y), hi16(w1.y)}, wd = {lo16(w1.z), hi16(w1.z), lo16(w1.w), hi16(w1.w)};
#pragma unroll
        for (int b = 0; b < NBATCH; ++b) { const f32x4* sh = (const f32x4*)(mod + (size_t)b * 6144 + 3072 + lane * 16);
            const f32x4 p = sh[0] * wa + sh[1] * wb + sh[2] * wc_ + sh[3] * wd; const float t = wave_sum((p[0] + p[1]) + (p[2] + p[3]));
            if (lane == 0) b2[(size_t)b * FF2 + n] = t; }
    }
}
namespace pg8 {
struct EpiAll {
    static constexpr bool PERM = true, AFTER_DRAIN = false;
    int mode; unsigned char* ws; const float* x; float* out; const float* g2;
    __device__ __forceinline__ void operator()(const f32x4 (&acc)[2][2][4][2], const Unit& u, int wr, int wc, int fr, int fq) const {
        float* mod = (float*)(ws + WS_MOD);
        if (mode < 0) return;
        switch (mode) {
        case 0: epi_bf16(acc, u, wr, wc, fr, fq, (bf16*)(ws + WS_Z), ZW); epi_sumsq(acc, u, wr, wc, fr, fq, (float*)(ws + WS_SSQ), (float*)(ws + WS_SSKV)); break;
        case 1: epi_up(acc, u, wr, wc, fr, fq, (bf16*)(ws + WS_Z), (const float*)(ws + WS_SS2), (const float*)(ws + WS_BIAS2)); break;
        case 2: epi_q(acc, u, wr, wc, fr, fq, (const float*)(ws + WS_SSQ), (bf16*)(ws + WS_QN), (bf16*)(ws + WS_QR)); break;
        case 3: epi_kv(acc, u, wr, wc, fr, fq, (const float*)(ws + WS_SSKV), (bf16*)(ws + WS_KN), (bf16*)(ws + WS_VT)); break;
        case 4: epi_t1(acc, u, wr, wc, fr, fq, (const bf16*)(ws + WS_Z), (bf16*)(ws + WS_T1), false); break;
        case 5: epi_t1(acc, u, wr, wc, fr, fq, (const bf16*)(ws + WS_Z), (bf16*)(ws + WS_T1), true); break;
        case 6: epi_x1(acc, u, wr, wc, fr, fq, x, mod, out, g2, (bf16*)(ws + WS_H), (float*)(ws + WS_SS2)); break;
        default: epi_res(acc, u, wr, wc, fr, fq, out, mod + 5120, out); break;
        }
    }
};
}

struct InProjOrder {
    pg8::StaticOrder base; int G, c;
    __device__ void init(int G_, int c_) { base.init(ML, ZW, G_, c_); G = G_; c = c_; }
    __device__ bool next(int i, pg8::Unit& u) const {
        const long L = (long)i * G + c;
        if (L < 128 * 19) return base.next(i, u);
        const int k = (int)L - 128 * 19; if (k >= 64) return false;
        const int j = k >> 3; u.pm = 128 + (k & 7); u.pn = j < 2 ? j + 1 : (j < 7 ? j + 2 : 10); return true;
    }
    __device__ __forceinline__ void a_ready(const pg8::Unit&) const {}
    __device__ __forceinline__ void done(const pg8::Unit&) const {}
};
DI void run_inproj(LAS unsigned char* lds, const Args& A) {
    pg8::Gemm g{(const bf16*)(A.ws + WS_H), (const bf16*)(A.ws + WS_WIN), MA, ZW, 1024, 1024}; InProjOrder S; S.init((int)gridDim.x, (int)blockIdx.x);
    pg8::EpiAll E{0, A.ws, A.in[0], A.out, A.in[18]};
    pg8::gemm_phase<pg8::EpiAll, InProjOrder, true, true>(lds, g, S, E);
}
DI void run_gemm(LAS unsigned char* lds, const Args& A, int mode, const bf16* Am, int lda, const bf16* Bt, int M, int N, int K) {
    pg8::Gemm g{Am, Bt, M, N, K, lda}; pg8::StaticOrder S; S.init(M, N, (int)gridDim.x, (int)blockIdx.x);
    pg8::EpiAll E{mode, A.ws, A.in[0], A.out, A.in[18]};
    pg8::gemm_phase<pg8::EpiAll, pg8::StaticOrder, true, true>(lds, g, S, E);
}

DI void ropek_phase(const Args& A, int tid) {
    const bf16* Z = (const bf16*)(A.ws + WS_Z); bf16* Kr = (bf16*)(A.ws + WS_KR);
    const int gt = blockIdx.x * 512 + tid, GT = gridDim.x * 512;
    for (int idx = gt; idx < MA * 8; idx += GT) { const int row = idx >> 3, g = idx & 7;
        const v2u w = *(const v2u*)(Z + (size_t)row * ZW + ZKR + 4 * g);
        float v0 = lo16(w.x), v1 = hi16(w.x), v2 = lo16(w.y), v3 = hi16(w.y);
        int b, key;
        if (row < ML) { b = row >> 12; key = row & 4095; const int r0 = 4 * g, a = r0 >> 4, i0 = (r0 & 15) >> 1; const float pos = a ? (float)(key & 63) : (float)(key >> 6);
            const float a0 = pos * rope_invf(i0), a1 = pos * rope_invf(i0 + 1); const float c0 = __cosf(a0), s0 = __sinf(a0), c1 = __cosf(a1), s1 = __sinf(a1);
            const float y0 = v0 * c0 - v1 * s0, y1 = v1 * c0 + v0 * s0, y2 = v2 * c1 - v3 * s1, y3 = v3 * c1 + v2 * s1; v0 = y0; v1 = y1; v2 = y2; v3 = y3; }
        else { const int r = row - ML; b = r >> 8; key = SEQ + (r & 255); }
        v2u o; o.x = pk2(v0, v1); o.y = pk2(v2, v3); *(v2u*)(Kr + ((size_t)b * LK + key) * 32 + 4 * g) = o; }
}

#define MFMA16(a, b, c) __builtin_amdgcn_mfma_f32_16x16x32_bf16((a), (b), (c), 0, 0, 0)
DI float logsig(float x) { return fminf(x, 0.f) - __logf(1.f + __expf(-fabsf(x))); }
constexpr int GP = 129;
constexpr int GL_GBUF = 0, GL_BLAST = 2 * 64 * GP * 4, GL_Y = 75776;
DI void gla_gates(LAS unsigned char* lds, const bf16* Z, int m0, int h, const float* wdec, const float* bdec, int tid, int wave, int lane) {
    LAS float* gbuf = (LAS float*)(lds + GL_GBUF); LAS float* blast = (LAS float*)(lds + GL_BLAST);
    {
        const int fr = lane & 15, fq = lane >> 4, dir = wave >> 2;
        bf16x8 af[4];
#pragma unroll
        for (int tb = 0; tb < 4; ++tb) af[tb] = *(const bf16x8*)(Z + (size_t)(m0 + tb * 16 + fr) * ZW + ZGL + fq * 8);
#pragma unroll
        for (int i = 0; i < 2; ++i) { const int d = ((wave & 3) * 2 + i) * 16 + fr;
            v4u bw = {0u, 0u, 0u, 0u};
            if ((fq >> 1) == dir) { const float* wp = wdec + (size_t)(dir * 16 + (fq & 1) * 8) * 512 + h * 128 + d;
                bw.x = pk2(wp[0], wp[512]); bw.y = pk2(wp[2 * 512], wp[3 * 512]); bw.z = pk2(wp[4 * 512], wp[5 * 512]); bw.w = pk2(wp[6 * 512], wp[7 * 512]); }
            const bf16x8 bfrag = __builtin_bit_cast(bf16x8, bw); const float bias = bdec[dir * 512 + h * 128 + d];
#pragma unroll
            for (int tb = 0; tb < 4; ++tb) { f32x4 acc = {0.f, 0.f, 0.f, 0.f}; acc = MFMA16(af[tb], bfrag, acc);
#pragma unroll
                for (int j = 0; j < 4; ++j) gbuf[(dir * 64 + tb * 16 + 4 * fq + j) * GP + d] = logsig(acc[j] + bias) * (1.f / 16.f); } }
    }
    __syncthreads();
    {
        const int d = tid & 127, dir = (tid >> 7) & 1, hf = tid >> 8; LAS float* g = gbuf + dir * (64 * GP) + d; LAS float* tot = blast + 256;
        float v[32];
#pragma unroll
        for (int i = 0; i < 32; ++i) v[i] = g[(hf * 32 + i) * GP];
        if (dir == 0) {
#pragma unroll
            for (int i = 1; i < 32; ++i) v[i] += v[i - 1];
            tot[(hf * 2 + dir) * 128 + d] = v[31];
        } else {
#pragma unroll
            for (int i = 30; i >= 0; --i) v[i] += v[i + 1];
            tot[(hf * 2 + dir) * 128 + d] = v[0];
        }
        __syncthreads();
        const float other = tot[((1 - hf) * 2 + dir) * 128 + d];
        const float add = (dir == 0) ? (hf == 1 ? other : 0.f) : (hf == 0 ? other : 0.f);
#pragma unroll
        for (int i = 0; i < 32; ++i) g[(hf * 32 + i) * GP] = v[i] + add;
        if (hf == 0) blast[dir * 128 + d] = ((dir == 0) ? other : v[0]) + ((dir == 0) ? v[31] : other);
    }
    __syncthreads();
}

DI void gla_a_unit(const Args& A, LAS unsigned char* lds, int u, int tid, int wave, int lane) {
    const bf16* Z = (const bf16*)(A.ws + WS_Z);
    int b, h, n, m0; const bool isctx = u >= 2048;
    if (!isctx) { b = u >> 8; h = (u >> 6) & 3; n = u & 63; m0 = b * SEQ + n * 64; } else { const int uc = u - 2048; b = uc >> 4; h = (uc >> 2) & 3; n = uc & 3; m0 = ML + b * CTX + n * 64; }
    gla_gates(lds, Z, m0, h, A.in[12], A.in[13], tid, wave, lane);
    LAS float* gbuf = (LAS float*)(lds + GL_GBUF); LAS float* blast = (LAS float*)(lds + GL_BLAST);
    LAS bf16* kdT = (LAS bf16*)(lds + GL_Y);
    LAS bf16* vT = (LAS bf16*)(lds + GL_Y + 36864);
    const int combo0 = (b * 4 + h) * 2;
    if (tid < 256) { const int dir = tid >> 7, d = tid & 127; ((float*)(A.ws + WS_DEC))[((size_t)(combo0 + dir) * 68 + (isctx ? n : 4 + n)) * 128 + d] = __expf(blast[dir * 128 + d]); }
#pragma unroll
    for (int it = 0; it < 2; ++it) { const int s = tid & 63, dg = (tid >> 6) + 8 * it;
        const v4u kw = *(const v4u*)(Z + (size_t)(m0 + s) * ZW + ZGK + h * 128 + dg * 8), vw = *(const v4u*)(Z + (size_t)(m0 + s) * ZW + ZGV + h * 128 + dg * 8);
#pragma unroll
        for (int e = 0; e < 8; ++e) { const int d = dg * 8 + e; const unsigned kwd = kw[e >> 1], vwd = vw[e >> 1]; const float kf = (e & 1) ? hi16(kwd) : lo16(kwd);
            const float ef = __expf(blast[d] - gbuf[s * GP + d]), eb = __expf(blast[128 + d] - gbuf[(64 + s) * GP + d]);
            kdT[d * 72 + s] = (bf16)f2bf(kf * ef); kdT[(128 + d) * 72 + s] = (bf16)f2bf(kf * eb); vT[d * 72 + s] = (bf16)((e & 1) ? (vwd >> 16) : (vwd & 0xffffu)); } }
    __syncthreads();
    const int fr = lane & 15, fq = lane >> 4, dir = wave >> 2, dkb0 = (wave & 3) * 2;
    bf16x8 af[2][2];
#pragma unroll
    for (int i = 0; i < 2; ++i)
#pragma unroll
        for (int ks = 0; ks < 2; ++ks) af[i][ks] = *(const LAS bf16x8*)(kdT + (dir * 128 + (dkb0 + i) * 16 + fr) * 72 + ks * 32 + fq * 8);
    bf16* dst = isctx ? (bf16*)(A.ws + WS_UCTX) + ((size_t)(combo0 + dir) * 4 + n) * 16384 : (bf16*)A.out + ((size_t)(combo0 + dir) * 64 + n) * 16384;
#pragma unroll 2
    for (int dvb = 0; dvb < 8; ++dvb) { const bf16x8 b0 = *(const LAS bf16x8*)(vT + (dvb * 16 + fr) * 72 + fq * 8), b1 = *(const LAS bf16x8*)(vT + (dvb * 16 + fr) * 72 + 32 + fq * 8);
#pragma unroll
        for (int i = 0; i < 2; ++i) { f32x4 acc = {0.f, 0.f, 0.f, 0.f}; acc = MFMA16(af[i][0], b0, acc); acc = MFMA16(af[i][1], b1, acc);
            v2u o; o.x = pk2(acc[0], acc[1]); o.y = pk2(acc[2], acc[3]); *(v2u*)(dst + (size_t)(dvb * 16 + fr) * 128 + (dkb0 + i) * 16 + 4 * fq) = o; } }
    __syncthreads();
}

DI void gla_scan(const Args& A, int tid, bool dry) {
    bf16* S = (bf16*)A.out; const bf16* Uctx = (const bf16*)(A.ws + WS_UCTX); const float* DEC = (const float*)(A.ws + WS_DEC);
    for (int item = blockIdx.x * 512 + tid; item < 64 * 2048; item += gridDim.x * 512) {
        const int combo = item >> 11, e = (item & 2047) * 8, dk0 = e & 127, dir = combo & 1;
        float s[8];
#pragma unroll
        for (int i = 0; i < 8; ++i) s[i] = 0.f;
        for (int step = 0; step < 4; ++step) { const int n = dir ? 3 - step : step;
            const v4u U = *(const v4u*)(Uctx + ((size_t)combo * 4 + n) * 16384 + e); const float* dp = DEC + ((size_t)combo * 68 + n) * 128 + dk0; const f32x4 d0 = *(const f32x4*)dp, d1 = *(const f32x4*)(dp + 4);
            s[0] = d0[0] * s[0] + lo16(U.x); s[1] = d0[1] * s[1] + hi16(U.x); s[2] = d0[2] * s[2] + lo16(U.y); s[3] = d0[3] * s[3] + hi16(U.y);
            s[4] = d1[0] * s[4] + lo16(U.z); s[5] = d1[1] * s[5] + hi16(U.z); s[6] = d1[2] * s[6] + lo16(U.w); s[7] = d1[3] * s[7] + hi16(U.w); }
#pragma unroll 8
        for (int step = 0; step < 64; ++step) { const int n = dir ? 63 - step : step; bf16* p = S + ((size_t)combo * 64 + n) * 16384 + e;
            const v4u U = *(const v4u*)p; const float* dp = DEC + ((size_t)combo * 68 + 4 + n) * 128 + dk0; const f32x4 d0 = *(const f32x4*)dp, d1 = *(const f32x4*)(dp + 4);
            v4u o; o.x = pk2(s[0], s[1]); o.y = pk2(s[2], s[3]); o.z = pk2(s[4], s[5]); o.w = pk2(s[6], s[7]); if (!dry) *(v4u*)p = o;
            s[0] = d0[0] * s[0] + lo16(U.x); s[1] = d0[1] * s[1] + hi16(U.x); s[2] = d0[2] * s[2] + lo16(U.y); s[3] = d0[3] * s[3] + hi16(U.y);
            s[4] = d1[0] * s[4] + lo16(U.z); s[5] = d1[1] * s[5] + hi16(U.z); s[6] = d1[2] * s[6] + lo16(U.w); s[7] = d1[3] * s[7] + hi16(U.w); }
    }
}

DI void gla_c_unit(const Args& A, LAS unsigned char* lds, int u, int tid, int wave, int lane) {
    const bf16* Z = (const bf16*)(A.ws + WS_Z);
    const int b = u >> 8, h = (u >> 6) & 3, n = u & 63, m0 = b * SEQ + n * 64;
    gla_gates(lds, Z, m0, h, A.in[12], A.in[13], tid, wave, lane);
    LAS float* gbuf = (LAS float*)(lds + GL_GBUF);
    LAS bf16* qk = (LAS bf16*)(lds + GL_Y);
#pragma unroll
    for (int it = 0; it < 2; ++it) { const int s = tid & 63, dg = (tid >> 6) + 8 * it;
        const v4u qw = *(const v4u*)(Z + (size_t)(m0 + s) * ZW + ZGQ + h * 128 + dg * 8), kw = *(const v4u*)(Z + (size_t)(m0 + s) * ZW + ZGK + h * 128 + dg * 8);
        float r0[8], r1[8], r2[8], r3[8];
#pragma unroll
        for (int e = 0; e < 8; ++e) { const int d = dg * 8 + e; const unsigned qwd = qw[e >> 1], kwd = kw[e >> 1];
            const float qf = ((e & 1) ? hi16(qwd) : lo16(qwd)) * GLA_QSCALE, kf = (e & 1) ? hi16(kwd) : lo16(kwd);
            const float bf_ = gbuf[s * GP + d], bb_ = gbuf[(64 + s) * GP + d];
            r0[e] = qf * __expf(bf_); r1[e] = kf * __expf(-bf_); r2[e] = qf * __expf(bb_); r3[e] = kf * __expf(-bb_); }
        v4u o;
        o.x = pk2(r0[0], r0[1]); o.y = pk2(r0[2], r0[3]); o.z = pk2(r0[4], r0[5]); o.w = pk2(r0[6], r0[7]); *(LAS v4u*)(qk + (0 * 64 + s) * 136 + dg * 8) = o;
        o.x = pk2(r1[0], r1[1]); o.y = pk2(r1[2], r1[3]); o.z = pk2(r1[4], r1[5]); o.w = pk2(r1[6], r1[7]); *(LAS v4u*)(qk + (1 * 64 + s) * 136 + dg * 8) = o;
        o.x = pk2(r2[0], r2[1]); o.y = pk2(r2[2], r2[3]); o.z = pk2(r2[4], r2[5]); o.w = pk2(r2[6], r2[7]); *(LAS v4u*)(qk + (2 * 64 + s) * 136 + dg * 8) = o;
        o.x = pk2(r3[0], r3[1]); o.y = pk2(r3[2], r3[3]); o.z = pk2(r3[4], r3[5]); o.w = pk2(r3[6], r3[7]); *(LAS v4u*)(qk + (3 * 64 + s) * 136 + dg * 8) = o; }
    __syncthreads();
    LAS bf16* vT = (LAS bf16*)lds;
    LAS bf16* Am = (LAS bf16*)(lds + 18432);
    LAS float* part = (LAS float*)(lds + 27648);
#pragma unroll
    for (int it = 0; it < 2; ++it) { const int s = tid & 63, dg = (tid >> 6) + 8 * it;
        const v4u vw = *(const v4u*)(Z + (size_t)(m0 + s) * ZW + ZGV + h * 128 + dg * 8);
#pragma unroll
        for (int e = 0; e < 8; ++e) { const unsigned vwd = vw[e >> 1]; vT[(dg * 8 + e) * 72 + s] = (bf16)((e & 1) ? (vwd >> 16) : (vwd & 0xffffu)); } }
    const int fr = lane & 15, fq = lane >> 4;
#pragma unroll
    for (int bi = 0; bi < 2; ++bi) { const int blk = wave * 2 + bi, ib = blk >> 2, sb = blk & 3;
        f32x4 af_ = {0.f, 0.f, 0.f, 0.f}, ab_ = {0.f, 0.f, 0.f, 0.f};
#pragma unroll
        for (int ks = 0; ks < 4; ++ks) {
            const bf16x8 q0 = *(const LAS bf16x8*)(qk + (0 * 64 + ib * 16 + fr) * 136 + ks * 32 + fq * 8), k0 = *(const LAS bf16x8*)(qk + (1 * 64 + sb * 16 + fr) * 136 + ks * 32 + fq * 8);
            const bf16x8 q1 = *(const LAS bf16x8*)(qk + (2 * 64 + ib * 16 + fr) * 136 + ks * 32 + fq * 8), k1 = *(const LAS bf16x8*)(qk + (3 * 64 + sb * 16 + fr) * 136 + ks * 32 + fq * 8);
            af_ = MFMA16(q0, k0, af_); ab_ = MFMA16(q1, k1, ab_); }
#pragma unroll
        for (int j = 0; j < 4; ++j) { const int i = ib * 16 + 4 * fq + j, s = sb * 16 + fr; const float val = (s <= i ? af_[j] : 0.f) + (s >= i ? ab_[j] : 0.f); Am[i * 72 + s] = (bf16)f2bf(val); } }
    __syncthreads();
    const int ib = wave & 3, dvh = wave >> 2; const int combo0 = (b * 4 + h) * 2;
    const bf16* Sf = (const bf16*)A.out + ((size_t)(combo0 + 0) * 64 + n) * 16384; const bf16* Sb = (const bf16*)A.out + ((size_t)(combo0 + 1) * 64 + n) * 16384;
    bf16x8 bam[2], bqf[4], bqb[4];
#pragma unroll
    for (int ks = 0; ks < 2; ++ks) bam[ks] = *(const LAS bf16x8*)(Am + (ib * 16 + fr) * 72 + ks * 32 + fq * 8);
#pragma unroll
    for (int ks = 0; ks < 4; ++ks) { bqf[ks] = *(const LAS bf16x8*)(qk + (0 * 64 + ib * 16 + fr) * 136 + ks * 32 + fq * 8); bqb[ks] = *(const LAS bf16x8*)(qk + (2 * 64 + ib * 16 + fr) * 136 + ks * 32 + fq * 8); }
    f32x4 o[4]; float ss = 0.f;
#pragma unroll
    for (int dvi = 0; dvi < 4; ++dvi) { const int dvb = dvh * 4 + dvi; f32x4 acc = {0.f, 0.f, 0.f, 0.f};
#pragma unroll
        for (int ks = 0; ks < 2; ++ks) { const bf16x8 a = *(const LAS bf16x8*)(vT + (dvb * 16 + fr) * 72 + ks * 32 + fq * 8); acc = MFMA16(a, bam[ks], acc); }
#pragma unroll
        for (int ks = 0; ks < 4; ++ks) { const bf16x8 a = *(const bf16x8*)(Sf + (size_t)(dvb * 16 + fr) * 128 + ks * 32 + fq * 8); acc = MFMA16(a, bqf[ks], acc); }
#pragma unroll
        for (int ks = 0; ks < 4; ++ks) { const bf16x8 a = *(const bf16x8*)(Sb + (size_t)(dvb * 16 + fr) * 128 + ks * 32 + fq * 8); acc = MFMA16(a, bqb[ks], acc); }
        o[dvi] = acc; ss += (acc[0] * acc[0] + acc[1] * acc[1]) + (acc[2] * acc[2] + acc[3] * acc[3]); }
    ss += __shfl_xor(ss, 16); ss += __shfl_xor(ss, 32);
    if (fq == 0) part[dvh * 64 + ib * 16 + fr] = ss;
    __syncthreads();
    const float rstd = __builtin_amdgcn_rsqf((part[ib * 16 + fr] + part[64 + ib * 16 + fr]) * (1.f / 128.f) + EPS);
    const int row = m0 + ib * 16 + fr; const float* ng = A.in[14]; bf16* Y = (bf16*)(A.ws + WS_Y);
#pragma unroll
    for (int dvi = 0; dvi < 4; ++dvi) { const int dv0 = (dvh * 4 + dvi) * 16 + 4 * fq; const f32x4 g = *(const f32x4*)(ng + dv0);
        const v2u rw = *(const v2u*)(Z + (size_t)row * ZW + ZGR + h * 128 + dv0);
        const float r0 = lo16(rw.x), r1 = hi16(rw.x), r2 = lo16(rw.y), r3 = hi16(rw.y);
        const float y0 = o[dvi][0] * rstd * g[0] * (r0 * sigmoidf_(r0)), y1 = o[dvi][1] * rstd * g[1] * (r1 * sigmoidf_(r1)), y2 = o[dvi][2] * rstd * g[2] * (r2 * sigmoidf_(r2)), y3 = o[dvi][3] * rstd * g[3] * (r3 * sigmoidf_(r3));
        v2u w; w.x = pk2(y0, y1); w.y = pk2(y2, y3); *(v2u*)(Y + (size_t)row * 512 + h * 128 + dv0) = w; }
    __syncthreads();
}

constexpr int AT_STAGE = 22528, AT_VOFF = 13312, AT_NT = LK / 64;
constexpr float AT_THR = 8.f;
DI void attn_qk(f32x4 (&st)[4][2], const LAS unsigned char* Kt, const bf16x8 (&qf)[2][3], float nm0, float nm1, int fr, int fq) {
#pragma unroll
    for (int kb = 0; kb < 4; ++kb) { st[kb][0] = (f32x4){nm0, nm0, nm0, nm0}; st[kb][1] = (f32x4){nm1, nm1, nm1, nm1};
#pragma unroll
        for (int ks = 0; ks < 3; ++ks) { const bf16x8 kf = *(const LAS bf16x8*)(Kt + (kb * 16 + fr) * 208 + ks * 64 + fq * 16);
            st[kb][0] = MFMA16(kf, qf[0][ks], st[kb][0]); st[kb][1] = MFMA16(kf, qf[1][ks], st[kb][1]); } }
}
DI void attn_unit(const Args& A, LAS unsigned char* lds, int u, int tid, int wave, int lane, bool dry) {
    const int bh = u >> 4, qb = u & 15, b = bh >> 3, h = bh & 7, fr = lane & 15, fq = lane >> 4;
    bf16* Qn = (bf16*)(A.ws + WS_QN); const bf16* Qr = (const bf16*)(A.ws + WS_QR);
    const bf16* Kn = (const bf16*)(A.ws + WS_KN) + (size_t)bh * LK * 64; const bf16* Kr = (const bf16*)(A.ws + WS_KR) + (size_t)b * LK * 32; const bf16* VT = (const bf16*)(A.ws + WS_VT) + (size_t)bh * 64 * LK;
    bf16x8 qf[2][3];
#pragma unroll
    for (int qq = 0; qq < 2; ++qq) { const size_t row = (size_t)b * SEQ + qb * 256 + wave * 32 + qq * 16 + fr;
        qf[qq][0] = *(const bf16x8*)(Qn + row * 512 + h * 64 + fq * 8); qf[qq][1] = *(const bf16x8*)(Qn + row * 512 + h * 64 + 32 + fq * 8); qf[qq][2] = *(const bf16x8*)(Qr + row * 256 + h * 32 + fq * 8); }
    f32x4 oacc[4][2];
#pragma unroll
    for (int i = 0; i < 4; ++i)
#pragma unroll
        for (int qq = 0; qq < 2; ++qq) oacc[i][qq] = (f32x4){0.f, 0.f, 0.f, 0.f};
    float mrun[2] = {0.f, 0.f}, lrun[2] = {0.f, 0.f};
    const int kkey = tid >> 3, kch = tid & 7, rkey = (tid >> 2) & 63, rch = tid & 3;
    v4u kreg, rreg = {0u, 0u, 0u, 0u}, vreg;
#define ATT_GLOAD(t) do { const int key0_ = (t) * 64; kreg = *(const v4u*)(Kn + (size_t)(key0_ + kkey) * 64 + kch * 8); if (tid < 256) rreg = *(const v4u*)(Kr + (size_t)(key0_ + rkey) * 32 + rch * 8); \
        vreg = *(const v4u*)(VT + (size_t)kkey * LK + key0_ + kch * 8); } while (0)
#define ATT_LSTORE(st_) do { LAS unsigned char* base_ = lds + (st_) * AT_STAGE; *(LAS v4u*)(base_ + kkey * 208 + kch * 16) = kreg; if (tid < 256) *(LAS v4u*)(base_ + rkey * 208 + 128 + rch * 16) = rreg; \
        *(LAS v4u*)(base_ + AT_VOFF + kkey * 144 + kch * 16) = vreg; } while (0)
#define ATT_STEP(T, CUR, NXT) do { \
        const int t_ = (T); const int sc_ = t_ % 3, sn_ = (t_ + 1) % 3, sl_ = (t_ + 2) % 3; \
        if (t_ + 2 < AT_NT) ATT_GLOAD(t_ + 2); \
        if (t_ + 1 < AT_NT) attn_qk(NXT, lds + sn_ * AT_STAGE, qf, -mrun[0], -mrun[1], fr, fq); \
        float mx_[2]; \
        _Pragma("unroll") for (int qq = 0; qq < 2; ++qq) { \
            float m_ = fmaxf(fmaxf(CUR[0][qq][0], CUR[0][qq][1]), fmaxf(CUR[0][qq][2], CUR[0][qq][3])); \
            _Pragma("unroll") for (int kb = 1; kb < 4; ++kb) m_ = fmaxf(m_, fmaxf(fmaxf(CUR[kb][qq][0], CUR[kb][qq][1]), fmaxf(CUR[kb][qq][2], CUR[kb][qq][3]))); \
            m_ = fmaxf(m_, __shfl_xor(m_, 16)); m_ = fmaxf(m_, __shfl_xor(m_, 32)); mx_[qq] = m_; } \
        if (__any((t_ == 0) || (mx_[0] > AT_THR) || (mx_[1] > AT_THR))) { \
            _Pragma("unroll") for (int qq = 0; qq < 2; ++qq) { const float dl_ = (t_ == 0) ? mx_[qq] : fmaxf(mx_[qq], 0.f), sf_ = __builtin_amdgcn_exp2f(-dl_); \
                mrun[qq] += dl_; lrun[qq] *= sf_; \
                _Pragma("unroll") for (int kb = 0; kb < 4; ++kb) { CUR[kb][qq] = CUR[kb][qq] - dl_; NXT[kb][qq] = NXT[kb][qq] - dl_; oacc[kb][qq] = oacc[kb][qq] * sf_; } } } \
        bf16x8 pf_[2][2]; \
        _Pragma("unroll") for (int qq = 0; qq < 2; ++qq) { float ps_ = 0.f; \
            _Pragma("unroll") for (int kb = 0; kb < 4; ++kb) _Pragma("unroll") for (int j = 0; j < 4; ++j) { const float p_ = __builtin_amdgcn_exp2f(CUR[kb][qq][j]); CUR[kb][qq][j] = p_; ps_ += p_; } \
            lrun[qq] += ps_; \
            _Pragma("unroll") for (int k2 = 0; k2 < 2; ++k2) pf_[k2][qq] = __builtin_bit_cast(bf16x8, pack8(CUR[2 * k2][qq], CUR[2 * k2 + 1][qq])); } \
        const LAS unsigned char* Vt_ = lds + sc_ * AT_STAGE + AT_VOFF; \
        _Pragma("unroll") for (int dvb = 0; dvb < 4; ++dvb) _Pragma("unroll") for (int k2 = 0; k2 < 2; ++k2) { const LAS unsigned char* vp_ = Vt_ + (dvb * 16 + fr) * 144 + (k2 * 32 + 4 * fq) * 2; \
            const v2u lo_ = *(const LAS v2u*)vp_, hi_ = *(const LAS v2u*)(vp_ + 32); v4u vv_; vv_.x = lo_.x; vv_.y = lo_.y; vv_.z = hi_.x; vv_.w = hi_.y; const bf16x8 vf_ = __builtin_bit_cast(bf16x8, vv_); \
            oacc[dvb][0] = MFMA16(vf_, pf_[k2][0], oacc[dvb][0]); oacc[dvb][1] = MFMA16(vf_, pf_[k2][1], oacc[dvb][1]); } \
        if (t_ + 2 < AT_NT) ATT_LSTORE(sl_); \
        __syncthreads(); } while (0)
    ATT_GLOAD(0); ATT_LSTORE(0); ATT_GLOAD(1); ATT_LSTORE(1); __syncthreads();
    f32x4 sta[4][2], stb[4][2];
    attn_qk(sta, lds, qf, 0.f, 0.f, fr, fq);
#pragma unroll
    for (int kb = 0; kb < 4; ++kb) { stb[kb][0] = (f32x4){0.f, 0.f, 0.f, 0.f}; stb[kb][1] = (f32x4){0.f, 0.f, 0.f, 0.f}; }
    for (int t = 0; t < AT_NT; t += 2) { ATT_STEP(t, sta, stb); ATT_STEP(t + 1, stb, sta); }
    if (!dry)
#pragma unroll
    for (int qq = 0; qq < 2; ++qq) { float l = lrun[qq]; l += __shfl_xor(l, 16); l += __shfl_xor(l, 32); const float inv = 1.f / l;
        const size_t row = (size_t)b * SEQ + qb * 256 + wave * 32 + qq * 16 + fr;
#pragma unroll
        for (int dvb = 0; dvb < 4; ++dvb) { const f32x4 o = oacc[dvb][qq] * inv; v2u w; w.x = pk2(o[0], o[1]); w.y = pk2(o[2], o[3]); *(v2u*)(Qn + row * 512 + h * 64 + dvb * 16 + 4 * fq) = w; } }
#undef ATT_STEP
#undef ATT_GLOAD
#undef ATT_LSTORE
}

DI float gelu1(float v) {
    const float av = fabsf(v), t = __builtin_amdgcn_rcpf(av * 0.2316418882f + 1.0f);
    float q = t * 0.5307027145f + (-0.7265760135f); q = q * t + 0.7107068705f; q = q * t + (-0.142248368f); q = q * t + 0.127414796f; q = q * t;
    const float e = __builtin_amdgcn_exp2f((v * v) * (-0.72134752044f)); const float m = v * (q * e);
    return v < 0.f ? m : v - m;
}
DI f32x2 up2(unsigned w) { return (f32x2){lo16(w), hi16(w)}; }
DI f32x2 gelu_pk(f32x2 v) {
    const f32x2 av = __builtin_elementwise_abs(v), d = av * 0.2316418882f + 1.0f;
    f32x2 t; t.x = __builtin_amdgcn_rcpf(d.x); t.y = __builtin_amdgcn_rcpf(d.y);
    f32x2 q = t * 0.5307027145f + (-0.7265760135f); q = q * t + 0.7107068705f; q = q * t + (-0.142248368f); q = q * t + 0.127414796f; q = q * t;
    const f32x2 s = (v * v) * (-0.72134752044f);
    f32x2 e; e.x = __builtin_amdgcn_exp2f(s.x); e.y = __builtin_amdgcn_exp2f(s.y);
    const f32x2 m = v * (q * e), r = v - m;
    f32x2 o; o.x = v.x < 0.f ? m.x : r.x; o.y = v.y < 0.f ? m.y : r.y; return o;
}
DI void conv_phase(const Args& A, int tid, bool dry) {
    bf16* VG = (bf16*)(A.ws + WS_Z); const bf16* cw = (const bf16*)(A.ws + WS_CONVW); const float* cb = A.in[21];
    const int gt = blockIdx.x * 512 + tid, GT = gridDim.x * 512;
    const v4u zero4 = {0u, 0u, 0u, 0u};
    for (int item = gt; item < NBATCH * 64 * 2 * 352; item += GT) {
        const int cgp = item % 352, rest = item / 352, half = rest & 1, r = (rest >> 1) & 63, b = rest >> 7, c0 = half * 32;
        f32x2 w[9][4];
#pragma unroll
        for (int tap = 0; tap < 9; ++tap) { const v4u ww = *(const v4u*)(cw + tap * FF + cgp * 8); w[tap][0] = up2(ww.x); w[tap][1] = up2(ww.y); w[tap][2] = up2(ww.z); w[tap][3] = up2(ww.w); }
        f32x2 bias[4]; { const f32x4 b0 = *(const f32x4*)(cb + cgp * 8), b1 = *(const f32x4*)(cb + cgp * 8 + 4); bias[0] = (f32x2){b0[0], b0[1]}; bias[1] = (f32x2){b0[2], b0[3]}; bias[2] = (f32x2){b1[0], b1[1]}; bias[3] = (f32x2){b1[2], b1[3]}; }
        const size_t m0 = (size_t)b * SEQ + r * 64;
        const bf16* gb = VG + FF + cgp * 8; bf16* vb = VG + cgp * 8;
        const bool ok0 = r > 0, ok2 = r < 63;
        v4u g[3][4];
#define CLOAD(dy, ok, c) (((ok) && (c) >= 0 && (c) < 64) ? *(const v4u*)(gb + (m0 + ((dy) - 1) * 64 + (c)) * FF2) : zero4)
        g[0][0] = zero4; g[1][0] = zero4; g[2][0] = zero4;
        g[0][1] = CLOAD(0, ok0, c0 - 1); g[1][1] = CLOAD(1, true, c0 - 1); g[2][1] = CLOAD(2, ok2, c0 - 1);
        g[0][2] = CLOAD(0, ok0, c0); g[1][2] = CLOAD(1, true, c0); g[2][2] = CLOAD(2, ok2, c0);
        g[0][3] = CLOAD(0, ok0, c0 + 1); g[1][3] = CLOAD(1, true, c0 + 1); g[2][3] = CLOAD(2, ok2, c0 + 1);
        v4u vnext = *(const v4u*)(vb + (m0 + c0) * FF2);
#pragma unroll 2
        for (int c = c0; c < c0 + 32; ++c) {
#pragma unroll
            for (int dy = 0; dy < 3; ++dy) { g[dy][0] = g[dy][1]; g[dy][1] = g[dy][2]; g[dy][2] = g[dy][3]; }
            g[0][3] = CLOAD(0, ok0, c + 2); g[1][3] = CLOAD(1, true, c + 2); g[2][3] = CLOAD(2, ok2, c + 2);
            const v4u vv = vnext; if (c + 1 < c0 + 32) vnext = *(const v4u*)(vb + (m0 + c + 1) * FF2);
            f32x2 acc[4] = {bias[0], bias[1], bias[2], bias[3]};
#pragma unroll
            for (int dy = 0; dy < 3; ++dy)
#pragma unroll
                for (int dx = 0; dx < 3; ++dx) { const v4u gg = g[dy][dx];
                    acc[0] += up2(gg.x) * w[dy * 3 + dx][0]; acc[1] += up2(gg.y) * w[dy * 3 + dx][1]; acc[2] += up2(gg.z) * w[dy * 3 + dx][2]; acc[3] += up2(gg.w) * w[dy * 3 + dx][3]; }
            const f32x2 o0 = gelu_pk(acc[0]) * up2(vv.x), o1 = gelu_pk(acc[1]) * up2(vv.y), o2 = gelu_pk(acc[2]) * up2(vv.z), o3 = gelu_pk(acc[3]) * up2(vv.w);
            v4u o; o.x = pk2(o0.x, o0.y); o.y = pk2(o1.x, o1.y); o.z = pk2(o2.x, o2.y); o.w = pk2(o3.x, o3.y);
            if (!dry) *(v4u*)(vb + (m0 + c) * FF2) = o;
        }
#undef CLOAD
    }
}

#define RLX_AGENT __ATOMIC_RELAXED, __HIP_MEMORY_SCOPE_AGENT
#define XB_TMO      128
#define XB_XCNT(j)  (256  + 64 * (j))
#define XB_XSUB(j)  (1280 + 64 * (j))
#define XB_XGEN(j)  (2304 + 64 * (j))
#define XB_TOP      3328
#define XB_TOPGEN   3392
#define XCD_BAR_WORDS 3456
#define XB_SPIN_CAP (1u << 18)

__device__ __forceinline__ unsigned xb_ld(unsigned* p)              { return __hip_atomic_load(p, __ATOMIC_RELAXED, __HIP_MEMORY_SCOPE_AGENT); }
__device__ __forceinline__ unsigned xb_add(unsigned* p, unsigned v) { return __hip_atomic_fetch_add(p, v, __ATOMIC_RELAXED, __HIP_MEMORY_SCOPE_AGENT); }
__device__ __forceinline__ unsigned xb_xcc_id() { return (unsigned)__builtin_amdgcn_s_getreg((3 << 11) | 20) & 0xFu; }
#define XB_SPIN(cond, bar) do { unsigned _sp = 0; while (cond) { __builtin_amdgcn_s_sleep(1); \
    if ((++_sp & 255u) == 0u) { if (xb_ld(&(bar)[XB_TMO])) break; if (_sp > XB_SPIN_CAP) { atomicAdd(&(bar)[XB_TMO], 1u); break; } } } } while (0)

struct XcdBarrier {
    unsigned* bar; unsigned x;
    volatile LAS unsigned* st;
};

__device__ __forceinline__ XcdBarrier xcd_barrier_post(unsigned* bar, volatile LAS unsigned* st) {
    XcdBarrier b; b.bar = bar; b.x = xb_xcc_id(); b.st = st;
    if (threadIdx.x == 0) (void)xb_add(&bar[XB_XCNT(b.x)], 1u);
    return b;
}
__device__ __forceinline__ void xcd_barrier_complete(unsigned* bar, unsigned x, unsigned& nloc, unsigned& nx) {
    const unsigned G = gridDim.x * gridDim.y * gridDim.z;
    unsigned sum, cnt, mine, sp = 0u;
    for (;;) {
        sum = 0u; cnt = 0u; mine = 0u;
#pragma unroll
        for (unsigned j = 0; j < 16; ++j) { const unsigned c = xb_ld(&bar[XB_XCNT(j)]); sum += c; cnt += (c > 0u) ? 1u : 0u; mine = (j == x) ? c : mine; }
        if (sum == G) break;
        __builtin_amdgcn_s_sleep(1);
        if ((++sp & 255u) == 0u) { if (xb_ld(&bar[XB_TMO])) break; if (sp > XB_SPIN_CAP) { atomicAdd(&bar[XB_TMO], 1u); break; } }
    }
    nloc = mine > 0u ? mine : 1u; nx = cnt > 0u ? cnt : 1u;
}

__device__ __forceinline__ void xcd_barrier(const XcdBarrier& b) {
    asm volatile("s_waitcnt vmcnt(0)" ::: "memory");
    __syncthreads();
    if (threadIdx.x == 0) {
        unsigned* bar = b.bar;
        __builtin_amdgcn_s_waitcnt(0);
        unsigned nloc = b.st[0], nx = b.st[1];
        if (nloc == 0u) { xcd_barrier_complete(bar, b.x, nloc, nx); b.st[0] = nloc; b.st[1] = nx; }
        const unsigned old = xb_add(&bar[XB_XSUB(b.x)], 1u);
        const unsigned gen = old / nloc;
        if (old + 1u == (gen + 1u) * nloc) {
            __builtin_amdgcn_fence(__ATOMIC_RELEASE, "agent");
            asm volatile("s_waitcnt vmcnt(0)" ::: "memory");
            const unsigned og = xb_add(&bar[XB_TOP], 1u);
            const unsigned tg = og / nx;
            if (og + 1u == (tg + 1u) * nx) xb_add(&bar[XB_TOPGEN], 1u);
            else XB_SPIN(xb_ld(&bar[XB_TOPGEN]) == tg, bar);
            __builtin_amdgcn_fence(__ATOMIC_ACQUIRE, "agent");
            xb_add(&bar[XB_XGEN(b.x)], 1u);
            asm volatile("s_waitcnt vmcnt(0)" ::: "memory");
        } else {
            XB_SPIN(xb_ld(&bar[XB_XGEN(b.x)]) == gen, bar);
            __builtin_amdgcn_fence(__ATOMIC_ACQUIRE, "agent");
            asm volatile("s_waitcnt vmcnt(0)" ::: "memory");
        }
    }
    __syncthreads();
}

#ifndef MK_DUP
#define MK_DUP 0
#endif
constexpr int LDS_BYTES = 147456;
constexpr int NPHASE = 13;
__global__ void __launch_bounds__(512, 2) mk_fwd(Args args) {
    extern __shared__ __attribute__((aligned(16))) unsigned char lds_raw[];
    LAS unsigned char* lds = (LAS unsigned char*)lds_raw;
    cg::grid_group grid = cg::this_grid();
    const int tid = threadIdx.x, lane = tid & 63, wave = __builtin_amdgcn_readfirstlane(tid >> 6);
    const int lo = args.ph_lo, hi = args.ph_hi;
    unsigned char* ws = args.ws;
    const int gw = blockIdx.x * 8 + wave, NGW = gridDim.x * 8;
    float* mod = (float*)(ws + WS_MOD);
#define IN(k) (lo <= (k) && (k) < hi)
    volatile LAS unsigned* bst = (volatile LAS unsigned*)(lds + LDS_BYTES - 64);
    if (tid < 2) bst[tid] = 0u;
    __syncthreads();
    XcdBarrier xbar = xcd_barrier_post((unsigned*)(ws + WS_BAR), bst);
    if (args.dup == 0x7fffffff) grid.sync();
#define SEAM(k) do { if (IN(k) && IN((k) + 1)) xcd_barrier(xbar); } while (0)
#define REP(bit) for (int rep_ = ((MK_DUP >> (bit)) & 1) ? 0 : 1; rep_ < 2; ++rep_)
#define DRY (rep_ == 0 && args.dup != 0)
    if (IN(0)) REP(0) { for (int it = blockIdx.x; it < 96; it += gridDim.x) p0_mod(args, (LAS float*)lds, tid, wave, lane, it); }
    SEAM(0);
    if (IN(1)) REP(1) {
        bf16* H = (bf16*)(ws + WS_H);
        for (int row = gw; row < MA; row += 2 * NGW) { const int r1 = row + NGW; const bool two = r1 < MA;
            const int b0 = row < ML ? (row >> 12) : 8, b1 = two ? (r1 < ML ? (r1 >> 12) : 8) : b0;
            const float* x0 = row < ML ? args.in[0] + (size_t)row * 1024 : args.in[2] + (size_t)(row - ML) * 1024;
            const float* x1 = two ? (r1 < ML ? args.in[0] + (size_t)r1 * 1024 : args.in[2] + (size_t)(r1 - ML) * 1024) : nullptr;
            rownorm_mod2(x0, x1, args.in[6], mod + b0 * 6144, mod + b0 * 6144 + 1024, mod + b1 * 6144, mod + b1 * 6144 + 1024, H + (size_t)row * 1024, H + (size_t)r1 * 1024, lane); }
        p0_transposes(args, lds, tid, wave, lane);
    }
    SEAM(1);
    if (IN(2)) run_inproj(lds, args);
    SEAM(2);
    if (IN(3)) {
        if ((MK_DUP >> 3) & 1) { run_gemm(lds, args, -args.dup, (const bf16*)(ws + WS_Z) + ZQ, ZW, (const bf16*)(ws + WS_WUQ), ML, 768, 384);
            run_gemm(lds, args, -args.dup, (const bf16*)(ws + WS_Z) + ZKV, ZW, (const bf16*)(ws + WS_WUKV), MA, 1024, 256); ropek_phase(args, tid); }
        run_gemm(lds, args, 2, (const bf16*)(ws + WS_Z) + ZQ, ZW, (const bf16*)(ws + WS_WUQ), ML, 768, 384);
        run_gemm(lds, args, 3, (const bf16*)(ws + WS_Z) + ZKV, ZW, (const bf16*)(ws + WS_WUKV), MA, 1024, 256);
        ropek_phase(args, tid);
        bias2_phase(args, wave, lane);
        REP(4) for (int u = (int)gridDim.x - 1 - (int)blockIdx.x; u < 2176; u += gridDim.x) gla_a_unit(args, lds, u, tid, wave, lane);
    }
    SEAM(3);
    if (IN(4)) {
        REP(5) gla_scan(args, tid, DRY);
        REP(6) for (int u = blockIdx.x; u < 1024; u += gridDim.x) attn_unit(args, lds, u, tid, wave, lane, DRY);
    }
    SEAM(4);
    if (IN(5)) {
        REP(7) for (int u = blockIdx.x; u < 2048; u += gridDim.x) gla_c_unit(args, lds, u, tid, wave, lane);
        { if ((MK_DUP >> 8) & 1) run_gemm(lds, args, -args.dup, (const bf16*)(ws + WS_QN), 512, (const bf16*)(ws + WS_WBRM), ML, 1024, 512); run_gemm(lds, args, 4, (const bf16*)(ws + WS_QN), 512, (const bf16*)(ws + WS_WBRM), ML, 1024, 512); }
    }
    SEAM(5);
    if (IN(6)) { if ((MK_DUP >> 9) & 1) run_gemm(lds, args, -args.dup, (const bf16*)(ws + WS_Y), 512, (const bf16*)(ws + WS_WBRG), ML, 1024, 512); run_gemm(lds, args, 5, (const bf16*)(ws + WS_Y), 512, (const bf16*)(ws + WS_WBRG), ML, 1024, 512); }
    SEAM(6);
    if (IN(7)) { if ((MK_DUP >> 10) & 1) run_gemm(lds, args, -args.dup, (const bf16*)(ws + WS_T1), 1024, (const bf16*)(ws + WS_WOUT), ML, 1024, 1024); run_gemm(lds, args, 6, (const bf16*)(ws + WS_T1), 1024, (const bf16*)(ws + WS_WOUT), ML, 1024, 1024); }
    SEAM(7);
    if (IN(9)) { if ((MK_DUP >> 12) & 1) run_gemm(lds, args, 1, (const bf16*)(ws + WS_H), 1024, (const bf16*)(ws + WS_WUP), ML, FF2, 1024); run_gemm(lds, args, 1, (const bf16*)(ws + WS_H), 1024, (const bf16*)(ws + WS_WUP), ML, FF2, 1024); }
    SEAM(9);
    if (IN(10)) REP(13) conv_phase(args, tid, DRY);
    SEAM(10);
    if (IN(11)) { if ((MK_DUP >> 14) & 1) run_gemm(lds, args, -args.dup, (const bf16*)(ws + WS_Z), FF2, (const bf16*)(ws + WS_WDOWN), ML, 1024, FF); run_gemm(lds, args, 7, (const bf16*)(ws + WS_Z), FF2, (const bf16*)(ws + WS_WDOWN), ML, 1024, FF); }
    if ((MK_DUP >> 16) & 1) { for (int i = 0; i < 10; ++i) xcd_barrier(xbar); }
    SEAM(11);
    if (IN(12)) {
        const float* fg = args.in[23];
        for (int row = gw; row < ML; row += 2 * NGW) { const int r1 = (row + NGW < ML) ? row + NGW : row;
            f32x4* xr0 = (f32x4*)(args.out + (size_t)row * 1024) + lane; f32x4* xr1 = (f32x4*)(args.out + (size_t)r1 * 1024) + lane; f32x4 v0[4], v1[4]; float s0 = 0.f, s1 = 0.f;
#pragma unroll
            for (int j = 0; j < 4; ++j) { v0[j] = xr0[64 * j]; v1[j] = xr1[64 * j]; }
#pragma unroll
            for (int j = 0; j < 4; ++j) { s0 += (v0[j].x * v0[j].x + v0[j].y * v0[j].y) + (v0[j].z * v0[j].z + v0[j].w * v0[j].w); s1 += (v1[j].x * v1[j].x + v1[j].y * v1[j].y) + (v1[j].z * v1[j].z + v1[j].w * v1[j].w); }
#pragma unroll
            for (int o = 1; o < 64; o <<= 1) { s0 += __shfl_xor(s0, o); s1 += __shfl_xor(s1, o); }
            const float q0 = __builtin_amdgcn_rsqf(s0 * (1.f / 1024.f) + EPS), q1 = __builtin_amdgcn_rsqf(s1 * (1.f / 1024.f) + EPS);
#pragma unroll
            for (int j = 0; j < 4; ++j) { const f32x4 gg = ((const f32x4*)fg)[lane + 64 * j]; xr0[64 * j] = v0[j] * q0 * gg; if (r1 != row) xr1[64 * j] = v1[j] * q1 * gg; } }
    }
#undef REP
#undef DRY
#undef IN
#undef SEAM
}

#ifndef MK_SPLIT
#define MK_SPLIT 0
#endif
extern "C" void kernel_launch(void* const* d_in, const int* in_sizes, int n_in, void* d_out, int out_size, void* d_ws, size_t ws_size, hipStream_t stream) {
    static int grid = 0;
    if (grid == 0) {
        if (n_in != 24 || out_size != ML * DM || ws_size < WS_END) { fprintf(stderr, "kernel_launch: unexpected shapes (n_in %d out %d ws %zu)\n", n_in, out_size, ws_size); grid = -1; return; }
        int dev = 0, cus = 0, per_cu = 0;
        hipGetDevice(&dev); hipDeviceGetAttribute(&cus, hipDeviceAttributeMultiprocessorCount, dev);
        if (hipFuncSetAttribute((const void*)mk_fwd, hipFuncAttributeMaxDynamicSharedMemorySize, LDS_BYTES) != hipSuccess) { fprintf(stderr, "kernel_launch: hipFuncSetAttribute failed\n"); grid = -1; return; }
        if (hipOccupancyMaxActiveBlocksPerMultiprocessor(&per_cu, (const void*)mk_fwd, 512, LDS_BYTES) != hipSuccess || per_cu < 1) { fprintf(stderr, "kernel_launch: occupancy query says %d\n", per_cu); per_cu = 1; }
        (void)hipGetLastError();
        grid = cus * 1;
        fprintf(stderr, "kernel_launch: grid %d (cus %d per_cu %d)\n", grid, cus, per_cu);
    }
    if (grid < 0) return;
    hipMemsetAsync((char*)d_ws, 0, WS_ZERO_BYTES, stream);
    Args a{};
    for (int i = 0; i < 24; ++i) a.in[i] = (const float*)d_in[i];
    a.out = (float*)d_out; a.ws = (unsigned char*)d_ws;
#if MK_SPLIT
    for (int ph = 0; ph < NPHASE; ++ph) { a.ph_lo = ph; a.ph_hi = ph + 1; void* kargs[] = {&a};
        hipError_t e = hipLaunchCooperativeKernel((const void*)mk_fwd, dim3(grid), dim3(512), kargs, LDS_BYTES, stream);
        if (e != hipSuccess) { fprintf(stderr, "cooperative launch failed (phase %d): %s\n", ph, hipGetErrorString(e)); break; } }
#else
    a.ph_lo = 0; a.ph_hi = NPHASE; a.dup = 1; void* kargs[] = {&a};
    hipError_t e = hipLaunchCooperativeKernel((const void*)mk_fwd, dim3(grid), dim3(512), kargs, LDS_BYTES, stream);
    if (e != hipSuccess) fprintf(stderr, "cooperative launch failed: %s (grid %d)\n", hipGetErrorString(e), grid);
#endif
}
```

```cpp
#include <hip/hip_runtime.h>
#include <hip/hip_cooperative_groups.h>
#include <cstdio>
#include <cstdint>
namespace cg = cooperative_groups;
namespace pg8 {
#define PG8_LAS __attribute__((address_space(3)))
typedef unsigned short bf16_t;
typedef short bf16x8 __attribute__((ext_vector_type(8)));
typedef float f32x4 __attribute__((ext_vector_type(4)));
typedef unsigned u32x4 __attribute__((ext_vector_type(4)));
constexpr int BM = 256, BK = 64, HALF = 128, HTB = HALF * BK * 2  , STAGE_BYTES = 8 * HTB, NXCD = 8, WGM = 8;

__host__ __device__ __forceinline__ int lds_byte(int r, int c) { const int st = (r >> 4) * 2 + (c >> 5), rr = r & 15, cc = c & 31, ob = rr * 64 + cc * 2; return st * 1024 + (ob ^ (((ob >> 9) & 1) << 5)); }
__host__ __device__ __forceinline__ void stage_rc(int b, int& R, int& C) { const int st = b / 1024, sb = b % 1024, swz = sb ^ (((sb >> 9) & 1) << 5); R = (st >> 1) * 16 + swz / 64; C = (st & 1) * 32 + (swz % 64) / 2; }
__host__ __device__ __forceinline__ int perm32(int rho) { const int n = rho >> 4, i = rho & 15; return 8 * (i >> 2) + 4 * n + (i & 3); }

struct Unit { int pm, pn; };
struct Gemm { const bf16_t* A; const bf16_t* Bt; int M, N, K, lda; };

struct StaticOrder {
    int nM, nN, nwg, G, c;
    __host__ __device__ void init(int M, int N, int G_, int c_) { nM = M / BM; nN = N / BM; nwg = nM * nN; G = G_; c = c_; }
    __host__ __device__ bool next(int i, Unit& u) const {
        const long L = (long)i * G + c; if (L >= nwg) return false;
        int wgid = (int)L; { const int q = nwg / NXCD, r = nwg % NXCD, xcd = wgid % NXCD, off = wgid / NXCD; wgid = (xcd < r ? xcd * (q + 1) : r * (q + 1) + (xcd - r) * q) + off; }
        const int nig = WGM * nN, gid = wgid / nig, fm = gid * WGM, gsz = (nM - fm) < WGM ? (nM - fm) : WGM;
        u.pm = fm + ((wgid % nig) % gsz); u.pn = (wgid % nig) / gsz; return true;
    }
    __device__ __forceinline__ void a_ready(const Unit&) const {}
    __device__ __forceinline__ void done(const Unit&) const {}
};


template <class Epi, class Sched, bool ALIGN_EPI = false, bool SP2 = false>
__device__ __forceinline__ void gemm_phase(PG8_LAS unsigned char* lds, const Gemm g, const Sched& S, const Epi& E) {
    const int tid = threadIdx.x, wid = __builtin_amdgcn_readfirstlane(tid >> 6), lane = tid & 63, wr = wid >> 2, wc = wid & 3, fr = lane & 15, fq = lane >> 4;
    const int K = g.K, nt = K / BK;
    unsigned voffA[2], voffB[2];
#pragma unroll
    for (int i = 0; i < 2; ++i) { int R, C; stage_rc(tid * 16 + i * 8192, R, C); const int Rb = Epi::PERM ? ((R & ~31) + perm32(R & 31)) : R;
        voffA[i] = (unsigned)(R * g.lda + C) * 2u; voffB[i] = (unsigned)(Rb * K + C) * 2u; }
    const size_t kstep = (size_t)(BK * 2);
    const size_t hstep = (size_t)HALF * K * 2;
    const size_t tstep = 2 * hstep; const size_t hstepA = (size_t)HALF * g.lda * 2, tstepA = 2 * hstepA;
    const unsigned ldsw = (unsigned)wid * 1024u;
    const int aoff = lds_byte(wr * 64 + fr, fq * 8), boff = lds_byte(wc * 32 + fr, fq * 8);
#define PG8_SA(b, h) (((b) * 2 + (h)) * HTB)
#define PG8_SB(b, h) ((4 + (b) * 2 + (h)) * HTB)
#define PG8_STAGE(bufoff, gbase, voff) do { _Pragma("unroll") for (int _i = 0; _i < 2; ++_i) \
        __builtin_amdgcn_global_load_lds((const unsigned*)((const char*)(gbase) + (voff)[_i]), (PG8_LAS unsigned*)(lds + (bufoff) + ldsw + _i * 8192), 16, 0, 0); } while (0)
#define PG8_LDA(dst, b, h) do { _Pragma("unroll") for (int m = 0; m < 4; ++m) _Pragma("unroll") for (int k = 0; k < 2; ++k) dst[m][k] = *(const PG8_LAS bf16x8*)(lds + PG8_SA(b, h) + aoff + m * 2048 + k * 1024); } while (0)
#define PG8_LDB(dst, b, h) do { _Pragma("unroll") for (int n = 0; n < 2; ++n) _Pragma("unroll") for (int k = 0; k < 2; ++k) dst[n][k] = *(const PG8_LAS bf16x8*)(lds + PG8_SB(b, h) + boff + n * 2048 + k * 1024); } while (0)
#define PG8_MMA(ai, bj, At, Bt) do { __builtin_amdgcn_s_setprio(1); _Pragma("unroll") for (int m = 0; m < 4; ++m) _Pragma("unroll") for (int n = 0; n < 2; ++n) _Pragma("unroll") for (int k = 0; k < 2; ++k) \
        acc[ai][bj][m][n] = __builtin_amdgcn_mfma_f32_16x16x32_bf16(Bt[n][k], At[m][k], acc[ai][bj][m][n], 0, 0, 0); __builtin_amdgcn_s_setprio(0); } while (0)
#define PG8_WAIT_V(n) asm volatile("s_waitcnt vmcnt(" #n ")" ::: "memory")
#define PG8_WAIT_L(n) asm volatile("s_waitcnt lgkmcnt(" #n ")" ::: "memory")
#define PG8_BAR __builtin_amdgcn_s_barrier()
#define PG8_SCHED __builtin_amdgcn_sched_barrier(0)
    Unit cur, nxt; int ui = 0;
    if (!S.next(0, cur)) return;
    f32x4 acc[2][2][4][2];
#pragma unroll
    for (int a = 0; a < 2; ++a)
#pragma unroll
        for (int b = 0; b < 2; ++b)
#pragma unroll
            for (int m = 0; m < 4; ++m)
#pragma unroll
                for (int n = 0; n < 2; ++n) acc[a][b][m][n] = (f32x4){0.f, 0.f, 0.f, 0.f};
    bf16x8 At[4][2], B0[2][2], B1[2][2];
    const char* cA = (const char*)g.A + (size_t)cur.pm * tstepA; const char* cB = (const char*)g.Bt + (size_t)cur.pn * tstep;
    S.a_ready(cur);
    if constexpr (SP2) {
        PG8_STAGE(PG8_SB(0, 0), cB, voffB); PG8_STAGE(PG8_SB(0, 1), cB + hstep, voffB); PG8_STAGE(PG8_SA(0, 0), cA, voffA); PG8_STAGE(PG8_SA(0, 1), cA + hstepA, voffA);
        if (wr == 1) PG8_BAR;
        PG8_WAIT_V(2); PG8_BAR;
        PG8_STAGE(PG8_SB(1, 0), cB + kstep, voffB); PG8_STAGE(PG8_SA(1, 0), cA + kstep, voffA); PG8_STAGE(PG8_SB(1, 1), cB + hstep + kstep, voffB);
        PG8_WAIT_V(6); PG8_BAR;
    } else {
        PG8_STAGE(PG8_SB(0, 0), cB, voffB); PG8_STAGE(PG8_SA(0, 0), cA, voffA); PG8_STAGE(PG8_SB(0, 1), cB + hstep, voffB); PG8_STAGE(PG8_SA(0, 1), cA + hstepA, voffA);
        if (wr == 1) PG8_BAR;
        PG8_WAIT_V(4); PG8_BAR;
        PG8_STAGE(PG8_SB(1, 0), cB + kstep, voffB); PG8_STAGE(PG8_SA(1, 0), cA + kstep, voffA); PG8_STAGE(PG8_SB(1, 1), cB + hstep + kstep, voffB);
        PG8_WAIT_V(6); PG8_BAR;
    }
    for (;;) {
        const bool has_next = S.next(ui + 1, nxt);
        const char* nA = has_next ? (const char*)g.A + (size_t)nxt.pm * tstepA : cA; const char* nB = has_next ? (const char*)g.Bt + (size_t)nxt.pn * tstep : cB;
        for (int t = 0; t < nt; t += 2) {
            const bool last = (t == nt - 2);
            const char* a1 = cA + (size_t)(t + 1) * kstep;
            const char* a2 = last ? nA : cA + (size_t)(t + 2) * kstep; const char* b2 = last ? nB : cB + (size_t)(t + 2) * kstep;
            const char* a3 = a2 + kstep; const char* b3 = b2 + kstep;
            if (last && has_next) S.a_ready(nxt);
            if constexpr (SP2) {
            PG8_LDB(B0, 0, 0); PG8_LDB(B1, 0, 1); PG8_SCHED; PG8_LDA(At, 0, 0); PG8_STAGE(PG8_SA(1, 1), a1 + hstepA, voffA);
            PG8_WAIT_V(8); PG8_WAIT_L(0); PG8_BAR; PG8_MMA(0, 0, At, B0); PG8_MMA(0, 1, At, B1); PG8_BAR; PG8_SCHED;
            PG8_LDA(At, 0, 1); PG8_STAGE(PG8_SB(0, 0), b2, voffB); PG8_STAGE(PG8_SB(0, 1), b2 + hstep, voffB); PG8_STAGE(PG8_SA(0, 0), a2, voffA);
            PG8_WAIT_V(8); PG8_WAIT_L(0); PG8_BAR; PG8_MMA(1, 0, At, B0); PG8_MMA(1, 1, At, B1); PG8_BAR; PG8_SCHED;
            PG8_LDB(B0, 1, 0); PG8_LDB(B1, 1, 1); PG8_SCHED; PG8_LDA(At, 1, 0); PG8_STAGE(PG8_SA(0, 1), a2 + hstepA, voffA);
            PG8_WAIT_V(8); PG8_WAIT_L(0); PG8_BAR; PG8_MMA(0, 0, At, B0); PG8_MMA(0, 1, At, B1); PG8_BAR; PG8_SCHED;
            PG8_LDA(At, 1, 1); PG8_STAGE(PG8_SB(1, 0), b3, voffB); PG8_STAGE(PG8_SB(1, 1), b3 + hstep, voffB); PG8_STAGE(PG8_SA(1, 0), a3, voffA);
            PG8_WAIT_V(8); PG8_WAIT_L(0); PG8_BAR; PG8_MMA(1, 0, At, B0); PG8_MMA(1, 1, At, B1); PG8_BAR; PG8_SCHED;
            } else {
            PG8_LDB(B0, 0, 0); PG8_SCHED; PG8_LDA(At, 0, 0); PG8_STAGE(PG8_SA(1, 1), a1 + hstepA, voffA);
            PG8_WAIT_L(8); PG8_BAR; PG8_WAIT_L(0); PG8_MMA(0, 0, At, B0); PG8_BAR; PG8_SCHED;
            PG8_LDB(B1, 0, 1); PG8_STAGE(PG8_SB(0, 0), b2, voffB);
            PG8_BAR; PG8_WAIT_L(0); PG8_MMA(0, 1, At, B1); PG8_BAR;
            PG8_LDA(At, 0, 1); PG8_STAGE(PG8_SA(0, 0), a2, voffA);
            PG8_BAR; PG8_WAIT_L(0); PG8_MMA(1, 0, At, B0); PG8_BAR; PG8_SCHED;
            PG8_STAGE(PG8_SB(0, 1), b2 + hstep, voffB);
            PG8_WAIT_V(6); PG8_BAR; PG8_MMA(1, 1, At, B1); PG8_BAR;
            PG8_LDB(B0, 1, 0); PG8_SCHED; PG8_LDA(At, 1, 0); PG8_STAGE(PG8_SA(0, 1), a2 + hstepA, voffA);
            PG8_WAIT_L(8); PG8_BAR; PG8_WAIT_L(0); PG8_MMA(0, 0, At, B0); PG8_BAR; PG8_SCHED;
            PG8_LDB(B1, 1, 1); PG8_STAGE(PG8_SB(1, 0), b3, voffB);
            PG8_BAR; PG8_WAIT_L(0); PG8_MMA(0, 1, At, B1); PG8_BAR;
            PG8_LDA(At, 1, 1); PG8_STAGE(PG8_SA(1, 0), a3, voffA);
            PG8_BAR; PG8_WAIT_L(0); PG8_MMA(1, 0, At, B0); PG8_BAR; PG8_SCHED;
            PG8_STAGE(PG8_SB(1, 1), b3 + hstep, voffB);
            PG8_WAIT_V(6); PG8_BAR; PG8_MMA(1, 1, At, B1); PG8_BAR;
            }
        }
        if constexpr (ALIGN_EPI) { if (wr == 0) PG8_BAR; }
        if constexpr (!Epi::AFTER_DRAIN) { E(acc, cur, wr, wc, fr, fq); S.done(cur); }
        if (!has_next) break;
#pragma unroll
        for (int a = 0; a < 2; ++a)
#pragma unroll
            for (int b = 0; b < 2; ++b)
#pragma unroll
                for (int m = 0; m < 4; ++m)
#pragma unroll
                    for (int n = 0; n < 2; ++n) acc[a][b][m][n] = (f32x4){0.f, 0.f, 0.f, 0.f};
        cur = nxt; cA = nA; cB = nB; ++ui;
        if constexpr (ALIGN_EPI) { if (wr == 1) PG8_BAR; }
    }
    PG8_WAIT_V(0);
    if constexpr (!ALIGN_EPI) { if (wr == 0) PG8_BAR; }
    PG8_BAR;
    if constexpr (Epi::AFTER_DRAIN) { E.fused(acc, cur, wr, wc, fr, fq, lds, wid, lane); S.done(cur); }
#undef PG8_SA
#undef PG8_SB
#undef PG8_STAGE
#undef PG8_LDA
#undef PG8_LDB
#undef PG8_MMA
#undef PG8_WAIT_V
#undef PG8_WAIT_L
#undef PG8_BAR
#undef PG8_SCHED
}
}
#define DI __device__ __forceinline__
#define LAS __attribute__((address_space(3)))
typedef unsigned short bf16;
typedef unsigned v4u __attribute__((ext_vector_type(4)));
typedef unsigned v2u __attribute__((ext_vector_type(2)));
typedef float f32x4 __attribute__((ext_vector_type(4)));
typedef float f32x2 __attribute__((ext_vector_type(2)));
typedef short bf16x8 __attribute__((ext_vector_type(8)));
typedef short s16x4 __attribute__((ext_vector_type(4)));

constexpr int DM = 1024, NBATCH = 8, SEQ = 4096, CTX = 256;
constexpr int ML = NBATCH * SEQ, MC = NBATCH * CTX, MA = ML + MC;
constexpr int ZW = 4864;
constexpr int ZQ = 0, ZKV = 384, ZKR = 640, ZGQ = 672, ZGK = 1184, ZGV = 1696, ZGR = 2208, ZGL = 2720, ZGM = 2752, ZGG = 3776;
constexpr int LK = SEQ + CTX;
constexpr int FF = 2816, FF2 = 5632;
constexpr float EPS = 1e-6f;
constexpr float QSCALE = 0.10206207261596577f * 1.4426950408889634f;
constexpr float GLA_QSCALE = 0.08838834764831845f;
constexpr size_t MiB = 1u << 20;
constexpr size_t WS_SSQ = 0, WS_SSKV = 256 * 1024, WS_BAR = 416 * 1024, WS_SS2 = 640 * 1024, WS_ZERO_BYTES = 1 * MiB, WS_MOD = 1 * MiB, WS_BIAS2 = 1 * MiB + 256 * 1024;
constexpr size_t WS_WIN = 2 * MiB, WS_WUQ = 12 * MiB, WS_WUKV = 13 * MiB, WS_WBRM = 14 * MiB, WS_WBRG = 15 * MiB, WS_WOUT = 16 * MiB, WS_WUP = 18 * MiB, WS_WDOWN = 29 * MiB, WS_CONVW = 35 * MiB;
constexpr size_t WS_H = 36 * MiB;
constexpr size_t WS_QN = 36 * MiB, WS_QR = 68 * MiB, WS_UCTX = 84 * MiB, WS_DEC = 92 * MiB, WS_Y = 68 * MiB;
constexpr size_t WS_Z = 104 * MiB;
constexpr size_t WS_KN = 427 * MiB, WS_VT = 461 * MiB, WS_KR = 495 * MiB, WS_T1 = 427 * MiB;
constexpr size_t WS_END = 512 * MiB;

struct Args {
    const float* in[24]; float* out; unsigned char* ws; int ph_lo, ph_hi, dup, pad;
};

DI float bf2f(unsigned u) { return __builtin_bit_cast(float, u << 16); }
DI unsigned pk2(float lo, float hi);
DI unsigned f2bf(float f) { return pk2(f, 0.f) & 0xffffu; }
typedef __bf16 bf16x2_t __attribute__((ext_vector_type(2)));
DI unsigned pk2(float lo, float hi) { const f32x2 v = {lo, hi}; const bf16x2_t b = __builtin_convertvector(v, bf16x2_t); return __builtin_bit_cast(unsigned, b); }
DI float lo16(unsigned w) { return __builtin_bit_cast(float, w << 16); }
DI float hi16(unsigned w) { return __builtin_bit_cast(float, w & 0xffff0000u); }
DI float wave_sum(float v) {
#pragma unroll
    for (int o = 1; o < 64; o <<= 1) v += __shfl_xor(v, o);
    return v;
}
DI float sigmoidf_(float x) { return 1.f / (1.f + __expf(-x)); }
DI float rope_invf(int i) { return __builtin_amdgcn_exp2f(-1.6609640474436813f * (float)i); }
DI int rope_perm(int r) { const int a = r >> 4, rr = r & 15, half = rr >> 3, i = rr & 7; return 16 * a + 2 * i + half; }

DI int perm_col(int mode, int n) {
    if (mode == 1) { const int h = n / 96, w = n - 96 * h; return (w >= 64) ? h * 96 + 64 + rope_perm(w - 64) : n; }
    if (mode == 2) { return (n >= ZKR && n < ZKR + 32) ? ZKR + rope_perm(n - ZKR) : n; }
    return n;
}
DI void p0_transpose_item(const float* W, int K, int N, bf16* WT, const float* kscale, int mode, LAS float* scr, int item, int lane) {
    const int nblk = N / 32, kb = item / nblk, nb = item % nblk, k0 = 64 * kb, n0 = 32 * nb;
#pragma unroll 8
    for (int i = 0; i < 32; ++i) { const int kk = 2 * i + (lane >> 5); scr[kk * 33 + (lane & 31)] = W[(size_t)(k0 + kk) * N + n0 + (lane & 31)]; }
    asm volatile("s_waitcnt lgkmcnt(0)" ::: "memory");
    const int c = lane & 7;
    float ks[8];
#pragma unroll
    for (int i = 0; i < 8; ++i) ks[i] = kscale ? kscale[k0 + 8 * c + i] : 1.f;
#pragma unroll
    for (int j = 0; j < 4; ++j) { const int n = (lane >> 3) + 8 * j; const LAS float* s = scr + (8 * c) * 33 + n;
        v4u o; o.x = pk2(s[0 * 33] * ks[0], s[1 * 33] * ks[1]); o.y = pk2(s[2 * 33] * ks[2], s[3 * 33] * ks[3]); o.z = pk2(s[4 * 33] * ks[4], s[5 * 33] * ks[5]); o.w = pk2(s[6 * 33] * ks[6], s[7 * 33] * ks[7]);
        *(v4u*)(WT + (size_t)perm_col(mode, n0 + n) * K + k0 + 8 * c) = o; }
    asm volatile("s_waitcnt lgkmcnt(0)" ::: "memory");
}

DI void p0_mod(const Args& A, LAS float* sc, int tid, int wave, int lane, int blk) {
    const float* c = A.in[1]; const float* cctx = A.in[3]; const float* w_ada = A.in[4]; const float* b_ada = A.in[5];
    float* mod = (float*)(A.ws + WS_MOD);
    for (int i = tid; i < 9 * 1024; i += 512) { const int r = i >> 10, k = i & 1023; const float v = (r < 8) ? c[r * 1024 + k] : cctx[k]; sc[i] = v / (1.f + __expf(-v)); }
    __syncthreads();
    const int col = blk * 64 + lane;
    float acc[9];
#pragma unroll
    for (int r = 0; r < 9; ++r) acc[r] = 0.f;
    for (int k = wave * 128; k < wave * 128 + 128; ++k) { const float w = w_ada[(size_t)k * 6144 + col];
#pragma unroll
        for (int r = 0; r < 9; ++r) acc[r] += sc[r * 1024 + k] * w; }
    LAS float* red = sc + 9 * 1024;
#pragma unroll
    for (int r = 0; r < 9; ++r) red[(wave * 9 + r) * 64 + lane] = acc[r];
    __syncthreads();
    for (int i = tid; i < 9 * 64; i += 512) { const int r = i >> 6, l = i & 63; float s = b_ada[blk * 64 + l];
#pragma unroll
        for (int w = 0; w < 8; ++w) s += red[(w * 9 + r) * 64 + l];
        mod[r * 6144 + blk * 64 + l] = s; }
    __syncthreads();
}

DI void p0_transposes(const Args& A, LAS unsigned char* lds, int tid, int wave, int lane) {
    unsigned char* ws = A.ws;
    LAS float* scr = (LAS float*)(lds + wave * 16384);
    const int gw = blockIdx.x * 8 + wave, NGW = gridDim.x * 8;
    constexpr int I1 = 16 * 150, I2 = 6 * 24, I3 = 4 * 32, I4 = 8 * 32, I5 = 8 * 32, I6 = 16 * 32, I7 = 16 * 176, I8 = 44 * 32;
    constexpr int NITEMS = I1 + I2 + I3 + I4 + I5 + I6 + I7 + I8;
    for (int it = gw; it < NITEMS; it += NGW) {
        int r = it;
        if (r < I1) { p0_transpose_item(A.in[7], 1024, 4800, (bf16*)(ws + WS_WIN), nullptr, 2, scr, r, lane); continue; } r -= I1;
        if (r < I2) { p0_transpose_item(A.in[9], 384, 768, (bf16*)(ws + WS_WUQ), A.in[8], 1, scr, r, lane); continue; } r -= I2;
        if (r < I3) { p0_transpose_item(A.in[11], 256, 1024, (bf16*)(ws + WS_WUKV), A.in[10], 0, scr, r, lane); continue; } r -= I3;
        if (r < I4) { p0_transpose_item(A.in[15], 512, 1024, (bf16*)(ws + WS_WBRM), nullptr, 0, scr, r, lane); continue; } r -= I4;
        if (r < I5) { p0_transpose_item(A.in[16], 512, 1024, (bf16*)(ws + WS_WBRG), nullptr, 0, scr, r, lane); continue; } r -= I5;
        if (r < I6) { p0_transpose_item(A.in[17], 1024, 1024, (bf16*)(ws + WS_WOUT), nullptr, 0, scr, r, lane); continue; } r -= I6;
        if (r < I7) { p0_transpose_item(A.in[19], 1024, 5632, (bf16*)(ws + WS_WUP), nullptr, 0, scr, r, lane); continue; } r -= I7;
        p0_transpose_item(A.in[22], 2816, 1024, (bf16*)(ws + WS_WDOWN), nullptr, 0, scr, r, lane);
    }
    const int gt = blockIdx.x * 512 + tid, GT = gridDim.x * 512;
    for (int i = gt; i < 64 * 1024 / 8; i += GT) *(v4u*)((bf16*)(ws + WS_WIN) + (size_t)4800 * 1024 + (size_t)i * 8) = (v4u){0u, 0u, 0u, 0u};
    for (int i = gt; i < 9 * FF / 2; i += GT) ((unsigned*)(ws + WS_CONVW))[i] = pk2(A.in[20][2 * i], A.in[20][2 * i + 1]);
}

DI void rownorm_fin(const f32x4 (&v)[4], float ssum, const float* g, const float* sh, const float* sc, bf16* orow, int lane) {
    const float rstd = __builtin_amdgcn_rsqf(ssum * (1.f / 1024.f) + EPS);
    v2u* o8 = (v2u*)orow + lane;
#pragma unroll
    for (int j = 0; j < 4; ++j) {
        const f32x4 gg = ((const f32x4*)g)[lane + 64 * j], ss = ((const f32x4*)sc)[lane + 64 * j], hh = ((const f32x4*)sh)[lane + 64 * j];
        const f32x4 y = v[j] * rstd * gg * (ss + 1.f) + hh;
        v2u w; w.x = pk2(y.x, y.y); w.y = pk2(y.z, y.w); o8[64 * j] = w; }
}
DI void rownorm_mod2(const float* x0, const float* x1, const float* g, const float* sh0, const float* sc0, const float* sh1, const float* sc1, bf16* o0, bf16* o1, int lane) {
    const f32x4* xr0 = (const f32x4*)x0 + lane; const f32x4* xr1 = (const f32x4*)(x1 ? x1 : x0) + lane;
    f32x4 v0[4], v1[4]; float s0 = 0.f, s1 = 0.f;
#pragma unroll
    for (int j = 0; j < 4; ++j) { v0[j] = xr0[64 * j]; v1[j] = xr1[64 * j]; }
#pragma unroll
    for (int j = 0; j < 4; ++j) { s0 += (v0[j].x * v0[j].x + v0[j].y * v0[j].y) + (v0[j].z * v0[j].z + v0[j].w * v0[j].w); s1 += (v1[j].x * v1[j].x + v1[j].y * v1[j].y) + (v1[j].z * v1[j].z + v1[j].w * v1[j].w); }
#pragma unroll
    for (int o = 1; o < 64; o <<= 1) { s0 += __shfl_xor(s0, o); s1 += __shfl_xor(s1, o); }
    rownorm_fin(v0, s0, g, sh0, sc0, o0, lane);
    if (x1) rownorm_fin(v1, s1, g, sh1, sc1, o1, lane);
}
typedef const f32x4 (&AccRef)[2][2][4][2];
DI v4u pack8(f32x4 v0, f32x4 v1) { v4u w; w.x = pk2(v0[0], v0[1]); w.y = pk2(v0[2], v0[3]); w.z = pk2(v1[0], v1[1]); w.w = pk2(v1[2], v1[3]); return w; }

DI void epi_bf16(AccRef acc, const pg8::Unit& u, int wr, int wc, int fr, int fq, bf16* O, int ldc) {
    const int row0 = u.pm * 256 + wr * 64 + fr, col0 = u.pn * 256 + wc * 32 + 8 * fq;
#pragma unroll
    for (int ai = 0; ai < 2; ++ai)
#pragma unroll
        for (int m = 0; m < 4; ++m) { bf16* rowp = O + (size_t)(row0 + ai * 128 + m * 16) * ldc + col0;
#pragma unroll
            for (int bj = 0; bj < 2; ++bj) *(v4u*)(rowp + bj * 128) = pack8(acc[ai][bj][m][0], acc[ai][bj][m][1]); }
}
DI void epi_sumsq(AccRef acc, const pg8::Unit& u, int wr, int wc, int fr, int fq, float* ssq, float* sskv) {
    if (u.pn > 2) return;
#pragma unroll
    for (int bj = 0; bj < 2; ++bj) { const int colb = u.pn * 256 + bj * 128; float* dst = colb < 384 ? ssq : (colb < 640 ? sskv : nullptr);
        if (dst) {
#pragma unroll
            for (int ai = 0; ai < 2; ++ai)
#pragma unroll
                for (int m = 0; m < 4; ++m) { const f32x4 a = acc[ai][bj][m][0], b = acc[ai][bj][m][1];
                    float s = (a[0] * a[0] + a[1] * a[1]) + (a[2] * a[2] + a[3] * a[3]) + (b[0] * b[0] + b[1] * b[1]) + (b[2] * b[2] + b[3] * b[3]);
                    s += __shfl_xor(s, 16); s += __shfl_xor(s, 32);
                    if (fq == 0) atomicAdd(dst + (u.pm * 256 + ai * 128 + wr * 64 + m * 16 + fr), s); } } }
}
DI void epi_q(AccRef acc, const pg8::Unit& u, int wr, int wc, int fr, int fq, const float* ssq, bf16* Qn, bf16* Qr) {
#pragma unroll
    for (int ai = 0; ai < 2; ++ai)
#pragma unroll
        for (int m = 0; m < 4; ++m) { const int row = u.pm * 256 + ai * 128 + wr * 64 + m * 16 + fr;
            const float rs = __builtin_amdgcn_rsqf(ssq[row] * (1.f / 384.f) + EPS) * QSCALE; const int t = row & 4095; const float prow = (float)(t >> 6), pcol = (float)(t & 63);
#pragma unroll
            for (int bj = 0; bj < 2; ++bj)
#pragma unroll
                for (int n = 0; n < 2; ++n) { const int col4 = u.pn * 256 + bj * 128 + wc * 32 + 8 * fq + 4 * n, h = col4 / 96, w = col4 - 96 * h; const f32x4 v = acc[ai][bj][m][n] * rs;
                    if (w < 64) { v2u o; o.x = pk2(v[0], v[1]); o.y = pk2(v[2], v[3]); *(v2u*)(Qn + (size_t)row * 512 + h * 64 + w) = o; }
                    else { const int r0 = w - 64, a = r0 >> 4, i0 = (r0 & 15) >> 1; const float pos = a ? pcol : prow;
                        const float a0 = pos * rope_invf(i0), a1 = pos * rope_invf(i0 + 1); const float c0 = __cosf(a0), s0 = __sinf(a0), c1 = __cosf(a1), s1 = __sinf(a1);
                        v2u o; o.x = pk2(v[0] * c0 - v[1] * s0, v[1] * c0 + v[0] * s0); o.y = pk2(v[2] * c1 - v[3] * s1, v[3] * c1 + v[2] * s1);
                        *(v2u*)(Qr + (size_t)row * 256 + h * 32 + r0) = o; } } }
}
DI void epi_kv(AccRef acc, const pg8::Unit& u, int wr, int wc, int fr, int fq, const float* sskv, bf16* Kn, bf16* VT) {
#pragma unroll
    for (int ai = 0; ai < 2; ++ai)
#pragma unroll
        for (int m = 0; m < 4; ++m) { const int row = u.pm * 256 + ai * 128 + wr * 64 + m * 16 + fr;
            const float rs = __builtin_amdgcn_rsqf(sskv[row] * (1.f / 256.f) + EPS);
            int b, key; if (row < ML) { b = row >> 12; key = row & 4095; } else { const int r = row - ML; b = r >> 8; key = SEQ + (r & 255); }
#pragma unroll
            for (int bj = 0; bj < 2; ++bj) { const int h = u.pn * 2 + bj; const f32x4 v0 = acc[ai][bj][m][0] * rs, v1 = acc[ai][bj][m][1] * rs;
                if (wc < 2) { *(v4u*)(Kn + ((size_t)(b * 8 + h) * LK + key) * 64 + wc * 32 + 8 * fq) = pack8(v0, v1); }
                else { bf16* p = VT + ((size_t)(b * 8 + h) * 64 + (wc - 2) * 32 + 8 * fq) * LK + key;
                    p[0] = (bf16)f2bf(v0[0]); p[LK] = (bf16)f2bf(v0[1]); p[2 * LK] = (bf16)f2bf(v0[2]); p[3 * LK] = (bf16)f2bf(v0[3]);
                    p[4 * LK] = (bf16)f2bf(v1[0]); p[5 * LK] = (bf16)f2bf(v1[1]); p[6 * LK] = (bf16)f2bf(v1[2]); p[7 * LK] = (bf16)f2bf(v1[3]); } } }
}
DI void epi_t1(AccRef acc, const pg8::Unit& u, int wr, int wc, int fr, int fq, const bf16* Z, bf16* T1, bool second) {
    const int goff = second ? ZGG : ZGM;
#pragma unroll
    for (int ai = 0; ai < 2; ++ai)
#pragma unroll
        for (int m = 0; m < 4; ++m) { const int row = u.pm * 256 + ai * 128 + wr * 64 + m * 16 + fr;
#pragma unroll
            for (int bj = 0; bj < 2; ++bj) { const int col8 = u.pn * 256 + bj * 128 + wc * 32 + 8 * fq;
                const v4u g = *(const v4u*)(Z + (size_t)row * ZW + goff + col8);
                f32x4 v0 = acc[ai][bj][m][0], v1 = acc[ai][bj][m][1];
                v0[0] *= sigmoidf_(lo16(g.x)); v0[1] *= sigmoidf_(hi16(g.x)); v0[2] *= sigmoidf_(lo16(g.y)); v0[3] *= sigmoidf_(hi16(g.y));
                v1[0] *= sigmoidf_(lo16(g.z)); v1[1] *= sigmoidf_(hi16(g.z)); v1[2] *= sigmoidf_(lo16(g.w)); v1[3] *= sigmoidf_(hi16(g.w));
                bf16* dst = T1 + (size_t)row * 1024 + col8;
                if (second) { const v4u t = *(const v4u*)dst;
                    v0[0] += lo16(t.x); v0[1] += hi16(t.x); v0[2] += lo16(t.y); v0[3] += hi16(t.y); v1[0] += lo16(t.z); v1[1] += hi16(t.z); v1[2] += lo16(t.w); v1[3] += hi16(t.w); }
                *(v4u*)dst = pack8(v0, v1); } }
}
DI void epi_res(AccRef acc, const pg8::Unit& u, int wr, int wc, int fr, int fq, const float* base, const float* gate, float* dst) {
#pragma unroll
    for (int ai = 0; ai < 2; ++ai)
#pragma unroll
        for (int m = 0; m < 4; ++m) { const int row = u.pm * 256 + ai * 128 + wr * 64 + m * 16 + fr; const float* gp = gate + (size_t)(row >> 12) * 6144;
#pragma unroll
            for (int bj = 0; bj < 2; ++bj)
#pragma unroll
                for (int n = 0; n < 2; ++n) { const int col4 = u.pn * 256 + bj * 128 + wc * 32 + 8 * fq + 4 * n;
                    const f32x4 xb = *(const f32x4*)(base + (size_t)row * 1024 + col4), gg = *(const f32x4*)(gp + col4);
                    *(f32x4*)(dst + (size_t)row * 1024 + col4) = xb + gg * acc[ai][bj][m][n]; } }
}
DI void epi_x1(AccRef acc, const pg8::Unit& u, int wr, int wc, int fr, int fq, const float* x, const float* mod, float* dst, const float* g2, bf16* H2, float* ss2) {
    const float* mb = mod + (size_t)((u.pm * 256) >> 12) * 6144;
    f32x4 gt[2][2], gm[2][2];
#pragma unroll
    for (int bj = 0; bj < 2; ++bj)
#pragma unroll
        for (int n = 0; n < 2; ++n) { const int col4 = u.pn * 256 + bj * 128 + wc * 32 + 8 * fq + 4 * n;
            gt[bj][n] = *(const f32x4*)(mb + 2048 + col4); gm[bj][n] = *(const f32x4*)(g2 + col4) * (*(const f32x4*)(mb + 4096 + col4) + 1.f); }
#pragma unroll
    for (int ai = 0; ai < 2; ++ai)
#pragma unroll
        for (int m = 0; m < 4; ++m) { const int row = u.pm * 256 + ai * 128 + wr * 64 + m * 16 + fr; float ssum = 0.f;
#pragma unroll
            for (int bj = 0; bj < 2; ++bj) { const int col8 = u.pn * 256 + bj * 128 + wc * 32 + 8 * fq;
                const f32x4 x0 = *(const f32x4*)(x + (size_t)row * 1024 + col8) + gt[bj][0] * acc[ai][bj][m][0], x1 = *(const f32x4*)(x + (size_t)row * 1024 + col8 + 4) + gt[bj][1] * acc[ai][bj][m][1];
                *(f32x4*)(dst + (size_t)row * 1024 + col8) = x0; *(f32x4*)(dst + (size_t)row * 1024 + col8 + 4) = x1;
                ssum += (x0[0] * x0[0] + x0[1] * x0[1]) + (x0[2] * x0[2] + x0[3] * x0[3]) + (x1[0] * x1[0] + x1[1] * x1[1]) + (x1[2] * x1[2] + x1[3] * x1[3]);
                *(v4u*)(H2 + (size_t)row * 1024 + col8) = pack8(x0 * gm[bj][0], x1 * gm[bj][1]); }
            ssum += __shfl_xor(ssum, 16); ssum += __shfl_xor(ssum, 32);
            if (fq == 0) atomicAdd(ss2 + row, ssum); }
}
DI void epi_up(AccRef acc, const pg8::Unit& u, int wr, int wc, int fr, int fq, bf16* VG, const float* ss2, const float* bias2) {
    const float* bb = bias2 + (size_t)((u.pm * 256) >> 12) * FF2;
    f32x4 bv[2][2];
#pragma unroll
    for (int bj = 0; bj < 2; ++bj)
#pragma unroll
        for (int n = 0; n < 2; ++n) bv[bj][n] = *(const f32x4*)(bb + u.pn * 256 + bj * 128 + wc * 32 + 8 * fq + 4 * n);
#pragma unroll
    for (int ai = 0; ai < 2; ++ai)
#pragma unroll
        for (int m = 0; m < 4; ++m) { const int row = u.pm * 256 + ai * 128 + wr * 64 + m * 16 + fr; const float rs = __builtin_amdgcn_rsqf(ss2[row] * (1.f / 1024.f) + EPS);
            bf16* rowp = VG + (size_t)row * FF2 + u.pn * 256 + wc * 32 + 8 * fq;
#pragma unroll
            for (int bj = 0; bj < 2; ++bj) *(v4u*)(rowp + bj * 128) = pack8(acc[ai][bj][m][0] * rs + bv[bj][0], acc[ai][bj][m][1] * rs + bv[bj][1]); }
}
DI void bias2_phase(const Args& A, int wave, int lane) {
    const bf16* Wup = (const bf16*)(A.ws + WS_WUP); const float* mod = (const float*)(A.ws + WS_MOD); float* b2 = (float*)(A.ws + WS_BIAS2);
    for (int n = blockIdx.x * 8 + wave; n < FF2; n += gridDim.x * 8) {
        const v4u w0 = *(const v4u*)(Wup + (size_t)n * 1024 + lane * 16), w1 = *(const v4u*)(Wup + (size_t)n * 1024 + lane * 16 + 8);
        const f32x4 wa = {lo16(w0.x), hi16(w0.x), lo16(w0.y), hi16(w0.y)}, wb = {lo16(w0.z), hi16(w0.z), lo16(w0.w), hi16(w0.w)}, wc_ = {lo16(w1.x), hi16(w1.x), lo16(w1.y), hi16(w1.y)}, wd = {lo16(w1.z), hi16(w1.z), lo16(w1.w), hi16(w1.w)};
#pragma unroll
        for (int b = 0; b < NBATCH; ++b) { const f32x4* sh = (const f32x4*)(mod + (size_t)b * 6144 + 3072 + lane * 16);
            const f32x4 p = sh[0] * wa + sh[1] * wb + sh[2] * wc_ + sh[3] * wd; const float t = wave_sum((p[0] + p[1]) + (p[2] + p[3]));
            if (lane == 0) b2[(size_t)b * FF2 + n] = t; }
    }
}
namespace pg8 {
struct EpiAll {
    static constexpr bool PERM = true, AFTER_DRAIN = false;
    int mode; unsigned char* ws; const float* x; float* out; const float* g2;
    __device__ __forceinline__ void operator()(const f32x4 (&acc)[2][2][4][2], const Unit& u, int wr, int wc, int fr, int fq) const {
        float* mod = (float*)(ws + WS_MOD);
        if (mode < 0) return;
        switch (mode) {
        case 0: epi_bf16(acc, u, wr, wc, fr, fq, (bf16*)(ws + WS_Z), ZW); epi_sumsq(acc, u, wr, wc, fr, fq, (float*)(ws + WS_SSQ), (float*)(ws + WS_SSKV)); break;
        case 1: epi_up(acc, u, wr, wc, fr, fq, (bf16*)(ws + WS_Z), (const float*)(ws + WS_SS2), (const float*)(ws + WS_BIAS2)); break;
        case 2: epi_q(acc, u, wr, wc, fr, fq, (const float*)(ws + WS_SSQ), (bf16*)(ws + WS_QN), (bf16*)(ws + WS_QR)); break;
        case 3: epi_kv(acc, u, wr, wc, fr, fq, (const float*)(ws + WS_SSKV), (bf16*)(ws + WS_KN), (bf16*)(ws + WS_VT)); break;
        case 4: epi_t1(acc, u, wr, wc, fr, fq, (const bf16*)(ws + WS_Z), (bf16*)(ws + WS_T1), false); break;
        case 5: epi_t1(acc, u, wr, wc, fr, fq, (const bf16*)(ws + WS_Z), (bf16*)(ws + WS_T1), true); break;
        case 6: epi_x1(acc, u, wr, wc, fr, fq, x, mod, out, g2, (bf16*)(ws + WS_H), (float*)(ws + WS_SS2)); break;
        default: epi_res(acc, u, wr, wc, fr, fq, out, mod + 5120, out); break;
        }
    }
};
}

struct InProjOrder {
    pg8::StaticOrder base; int G, c;
    __device__ void init(int G_, int c_) { base.init(ML, ZW, G_, c_); G = G_; c = c_; }
    __device__ bool next(int i, pg8::Unit& u) const {
        const long L = (long)i * G + c;
        if (L < 128 * 19) return base.next(i, u);
        const int k = (int)L - 128 * 19; if (k >= 64) return false;
        const int j = k >> 3; u.pm = 128 + (k & 7); u.pn = j < 2 ? j + 1 : (j < 7 ? j + 2 : 10); return true;
    }
    __device__ __forceinline__ void a_ready(const pg8::Unit&) const {}
    __device__ __forceinline__ void done(const pg8::Unit&) const {}
};
DI void run_inproj(LAS unsigned char* lds, const Args& A) {
    pg8::Gemm g{(const bf16*)(A.ws + WS_H), (const bf16*)(A.ws + WS_WIN), MA, ZW, 1024, 1024}; InProjOrder S; S.init((int)gridDim.x, (int)blockIdx.x);
    pg8::EpiAll E{0, A.ws, A.in[0], A.out, A.in[18]};
    pg8::gemm_phase<pg8::EpiAll, InProjOrder, true, true>(lds, g, S, E);
}
DI void run_gemm(LAS unsigned char* lds, const Args& A, int mode, const bf16* Am, int lda, const bf16* Bt, int M, int N, int K) {
    pg8::Gemm g{Am, Bt, M, N, K, lda}; pg8::StaticOrder S; S.init(M, N, (int)gridDim.x, (int)blockIdx.x);
    pg8::EpiAll E{mode, A.ws, A.in[0], A.out, A.in[18]};
    pg8::gemm_phase<pg8::EpiAll, pg8::StaticOrder, true, true>(lds, g, S, E);
}

DI void ropek_phase(const Args& A, int tid) {
    const bf16* Z = (const bf16*)(A.ws + WS_Z); bf16* Kr = (bf16*)(A.ws + WS_KR);
    const int gt = blockIdx.x * 512 + tid, GT = gridDim.x * 512;
    for (int idx = gt; idx < MA * 8; idx += GT) { const int row = idx >> 3, g = idx & 7;
        const v2u w = *(const v2u*)(Z + (size_t)row * ZW + ZKR + 4 * g);
        float v0 = lo16(w.x), v1 = hi16(w.x), v2 = lo16(w.y), v3 = hi16(w.y);
        int b, key;
        if (row < ML) { b = row >> 12; key = row & 4095; const int r0 = 4 * g, a = r0 >> 4, i0 = (r0 & 15) >> 1; const float pos = a ? (float)(key & 63) : (float)(key >> 6);
            const float a0 = pos * rope_invf(i0), a1 = pos * rope_invf(i0 + 1); const float c0 = __cosf(a0), s0 = __sinf(a0), c1 = __cosf(a1), s1 = __sinf(a1);
            const float y0 = v0 * c0 - v1 * s0, y1 = v1 * c0 + v0 * s0, y2 = v2 * c1 - v3 * s1, y3 = v3 * c1 + v2 * s1; v0 = y0; v1 = y1; v2 = y2; v3 = y3; }
        else { const int r = row - ML; b = r >> 8; key = SEQ + (r & 255); }
        v2u o; o.x = pk2(v0, v1); o.y = pk2(v2, v3); *(v2u*)(Kr + ((size_t)b * LK + key) * 32 + 4 * g) = o; }
}

#define MFMA16(a, b, c) __builtin_amdgcn_mfma_f32_16x16x32_bf16((a), (b), (c), 0, 0, 0)
DI float logsig(float x) { return fminf(x, 0.f) - __logf(1.f + __expf(-fabsf(x))); }
constexpr int GP = 129;
constexpr int GL_GBUF = 0, GL_BLAST = 2 * 64 * GP * 4, GL_Y = 75776;
DI void gla_gates(LAS unsigned char* lds, const bf16* Z, int m0, int h, const float* wdec, const float* bdec, int tid, int wave, int lane) {
    LAS float* gbuf = (LAS float*)(lds + GL_GBUF); LAS float* blast = (LAS float*)(lds + GL_BLAST);
    {
        const int fr = lane & 15, fq = lane >> 4, dir = wave >> 2;
        bf16x8 af[4];
#pragma unroll
        for (int tb = 0; tb < 4; ++tb) af[tb] = *(const bf16x8*)(Z + (size_t)(m0 + tb * 16 + fr) * ZW + ZGL + fq * 8);
#pragma unroll
        for (int i = 0; i < 2; ++i) { const int d = ((wave & 3) * 2 + i) * 16 + fr;
            v4u bw = {0u, 0u, 0u, 0u};
            if ((fq >> 1) == dir) { const float* wp = wdec + (size_t)(dir * 16 + (fq & 1) * 8) * 512 + h * 128 + d;
                bw.x = pk2(wp[0], wp[512]); bw.y = pk2(wp[2 * 512], wp[3 * 512]); bw.z = pk2(wp[4 * 512], wp[5 * 512]); bw.w = pk2(wp[6 * 512], wp[7 * 512]); }
            const bf16x8 bfrag = __builtin_bit_cast(bf16x8, bw); const float bias = bdec[dir * 512 + h * 128 + d];
#pragma unroll
            for (int tb = 0; tb < 4; ++tb) { f32x4 acc = {0.f, 0.f, 0.f, 0.f}; acc = MFMA16(af[tb], bfrag, acc);
#pragma unroll
                for (int j = 0; j < 4; ++j) gbuf[(dir * 64 + tb * 16 + 4 * fq + j) * GP + d] = logsig(acc[j] + bias) * (1.f / 16.f); } }
    }
    __syncthreads();
    {
        const int d = tid & 127, dir = (tid >> 7) & 1, hf = tid >> 8; LAS float* g = gbuf + dir * (64 * GP) + d; LAS float* tot = blast + 256;
        float v[32];
#pragma unroll
        for (int i = 0; i < 32; ++i) v[i] = g[(hf * 32 + i) * GP];
        if (dir == 0) {
#pragma unroll
            for (int i = 1; i < 32; ++i) v[i] += v[i - 1];
            tot[(hf * 2 + dir) * 128 + d] = v[31];
        } else {
#pragma unroll
            for (int i = 30; i >= 0; --i) v[i] += v[i + 1];
            tot[(hf * 2 + dir) * 128 + d] = v[0];
        }
        __syncthreads();
        const float other = tot[((1 - hf) * 2 + dir) * 128 + d];
        const float add = (dir == 0) ? (hf == 1 ? other : 0.f) : (hf == 0 ? other : 0.f);
#pragma unroll
        for (int i = 0; i < 32; ++i) g[(hf * 32 + i) * GP] = v[i] + add;
        if (hf == 0) blast[dir * 128 + d] = ((dir == 0) ? other : v[0]) + ((dir == 0) ? v[31] : other);
    }
    __syncthreads();
}

DI void gla_a_unit(const Args& A, LAS unsigned char* lds, int u, int tid, int wave, int lane) {
    const bf16* Z = (const bf16*)(A.ws + WS_Z);
    int b, h, n, m0; const bool isctx = u >= 2048;
    if (!isctx) { b = u >> 8; h = (u >> 6) & 3; n = u & 63; m0 = b * SEQ + n * 64; } else { const int uc = u - 2048; b = uc >> 4; h = (uc >> 2) & 3; n = uc & 3; m0 = ML + b * CTX + n * 64; }
    gla_gates(lds, Z, m0, h, A.in[12], A.in[13], tid, wave, lane);
    LAS float* gbuf = (LAS float*)(lds + GL_GBUF); LAS float* blast = (LAS float*)(lds + GL_BLAST);
    LAS bf16* kdT = (LAS bf16*)(lds + GL_Y);
    LAS bf16* vT = (LAS bf16*)(lds + GL_Y + 36864);
    const int combo0 = (b * 4 + h) * 2;
    if (tid < 256) { const int dir = tid >> 7, d = tid & 127; ((float*)(A.ws + WS_DEC))[((size_t)(combo0 + dir) * 68 + (isctx ? n : 4 + n)) * 128 + d] = __expf(blast[dir * 128 + d]); }
#pragma unroll
    for (int it = 0; it < 2; ++it) { const int s = tid & 63, dg = (tid >> 6) + 8 * it;
        const v4u kw = *(const v4u*)(Z + (size_t)(m0 + s) * ZW + ZGK + h * 128 + dg * 8), vw = *(const v4u*)(Z + (size_t)(m0 + s) * ZW + ZGV + h * 128 + dg * 8);
#pragma unroll
        for (int e = 0; e < 8; ++e) { const int d = dg * 8 + e; const unsigned kwd = kw[e >> 1], vwd = vw[e >> 1]; const float kf = (e & 1) ? hi16(kwd) : lo16(kwd);
            const float ef = __expf(blast[d] - gbuf[s * GP + d]), eb = __expf(blast[128 + d] - gbuf[(64 + s) * GP + d]);
            kdT[d * 72 + s] = (bf16)f2bf(kf * ef); kdT[(128 + d) * 72 + s] = (bf16)f2bf(kf * eb); vT[d * 72 + s] = (bf16)((e & 1) ? (vwd >> 16) : (vwd & 0xffffu)); } }
    __syncthreads();
    const int fr = lane & 15, fq = lane >> 4, dir = wave >> 2, dkb0 = (wave & 3) * 2;
    bf16x8 af[2][2];
#pragma unroll
    for (int i = 0; i < 2; ++i)
#pragma unroll
        for (int ks = 0; ks < 2; ++ks) af[i][ks] = *(const LAS bf16x8*)(kdT + (dir * 128 + (dkb0 + i) * 16 + fr) * 72 + ks * 32 + fq * 8);
    bf16* dst = isctx ? (bf16*)(A.ws + WS_UCTX) + ((size_t)(combo0 + dir) * 4 + n) * 16384 : (bf16*)A.out + ((size_t)(combo0 + dir) * 64 + n) * 16384;
#pragma unroll 2
    for (int dvb = 0; dvb < 8; ++dvb) { const bf16x8 b0 = *(const LAS bf16x8*)(vT + (dvb * 16 + fr) * 72 + fq * 8), b1 = *(const LAS bf16x8*)(vT + (dvb * 16 + fr) * 72 + 32 + fq * 8);
#pragma unroll
        for (int i = 0; i < 2; ++i) { f32x4 acc = {0.f, 0.f, 0.f, 0.f}; acc = MFMA16(af[i][0], b0, acc); acc = MFMA16(af[i][1], b1, acc);
            v2u o; o.x = pk2(acc[0], acc[1]); o.y = pk2(acc[2], acc[3]); *(v2u*)(dst + (size_t)(dvb * 16 + fr) * 128 + (dkb0 + i) * 16 + 4 * fq) = o; } }
    __syncthreads();
}

DI void gla_scan(const Args& A, int tid, bool dry) {
    bf16* S = (bf16*)A.out; const bf16* Uctx = (const bf16*)(A.ws + WS_UCTX); const float* DEC = (const float*)(A.ws + WS_DEC);
    for (int item = blockIdx.x * 512 + tid; item < 64 * 2048; item += gridDim.x * 512) {
        const int combo = item >> 11, e = (item & 2047) * 8, dk0 = e & 127, dir = combo & 1;
        float s[8];
#pragma unroll
        for (int i = 0; i < 8; ++i) s[i] = 0.f;
        for (int step = 0; step < 4; ++step) { const int n = dir ? 3 - step : step;
            const v4u U = *(const v4u*)(Uctx + ((size_t)combo * 4 + n) * 16384 + e); const float* dp = DEC + ((size_t)combo * 68 + n) * 128 + dk0; const f32x4 d0 = *(const f32x4*)dp, d1 = *(const f32x4*)(dp + 4);
            s[0] = d0[0] * s[0] + lo16(U.x); s[1] = d0[1] * s[1] + hi16(U.x); s[2] = d0[2] * s[2] + lo16(U.y); s[3] = d0[3] * s[3] + hi16(U.y);
            s[4] = d1[0] * s[4] + lo16(U.z); s[5] = d1[1] * s[5] + hi16(U.z); s[6] = d1[2] * s[6] + lo16(U.w); s[7] = d1[3] * s[7] + hi16(U.w); }
#pragma unroll 8
        for (int step = 0; step < 64; ++step) { const int n = dir ? 63 - step : step; bf16* p = S + ((size_t)combo * 64 + n) * 16384 + e;
            const v4u U = *(const v4u*)p; const float* dp = DEC + ((size_t)combo * 68 + 4 + n) * 128 + dk0; const f32x4 d0 = *(const f32x4*)dp, d1 = *(const f32x4*)(dp + 4);
            v4u o; o.x = pk2(s[0], s[1]); o.y = pk2(s[2], s[3]); o.z = pk2(s[4], s[5]); o.w = pk2(s[6], s[7]); if (!dry) *(v4u*)p = o;
            s[0] = d0[0] * s[0] + lo16(U.x); s[1] = d0[1] * s[1] + hi16(U.x); s[2] = d0[2] * s[2] + lo16(U.y); s[3] = d0[3] * s[3] + hi16(U.y);
            s[4] = d1[0] * s[4] + lo16(U.z); s[5] = d1[1] * s[5] + hi16(U.z); s[6] = d1[2] * s[6] + lo16(U.w); s[7] = d1[3] * s[7] + hi16(U.w); }
    }
}

DI void gla_c_unit(const Args& A, LAS unsigned char* lds, int u, int tid, int wave, int lane) {
    const bf16* Z = (const bf16*)(A.ws + WS_Z);
    const int b = u >> 8, h = (u >> 6) & 3, n = u & 63, m0 = b * SEQ + n * 64;
    gla_gates(lds, Z, m0, h, A.in[12], A.in[13], tid, wave, lane);
    LAS float* gbuf = (LAS float*)(lds + GL_GBUF);
    LAS bf16* qk = (LAS bf16*)(lds + GL_Y);
#pragma unroll
    for (int it = 0; it < 2; ++it) { const int s = tid & 63, dg = (tid >> 6) + 8 * it;
        const v4u qw = *(const v4u*)(Z + (size_t)(m0 + s) * ZW + ZGQ + h * 128 + dg * 8), kw = *(const v4u*)(Z + (size_t)(m0 + s) * ZW + ZGK + h * 128 + dg * 8);
        float r0[8], r1[8], r2[8], r3[8];
#pragma unroll
        for (int e = 0; e < 8; ++e) { const int d = dg * 8 + e; const unsigned qwd = qw[e >> 1], kwd = kw[e >> 1];
            const float qf = ((e & 1) ? hi16(qwd) : lo16(qwd)) * GLA_QSCALE, kf = (e & 1) ? hi16(kwd) : lo16(kwd);
            const float bf_ = gbuf[s * GP + d], bb_ = gbuf[(64 + s) * GP + d];
            r0[e] = qf * __expf(bf_); r1[e] = kf * __expf(-bf_); r2[e] = qf * __expf(bb_); r3[e] = kf * __expf(-bb_); }
        v4u o;
        o.x = pk2(r0[0], r0[1]); o.y = pk2(r0[2], r0[3]); o.z = pk2(r0[4], r0[5]); o.w = pk2(r0[6], r0[7]); *(LAS v4u*)(qk + (0 * 64 + s) * 136 + dg * 8) = o;
        o.x = pk2(r1[0], r1[1]); o.y = pk2(r1[2], r1[3]); o.z = pk2(r1[4], r1[5]); o.w = pk2(r1[6], r1[7]); *(LAS v4u*)(qk + (1 * 64 + s) * 136 + dg * 8) = o;
        o.x = pk2(r2[0], r2[1]); o.y = pk2(r2[2], r2[3]); o.z = pk2(r2[4], r2[5]); o.w = pk2(r2[6], r2[7]); *(LAS v4u*)(qk + (2 * 64 + s) * 136 + dg * 8) = o;
        o.x = pk2(r3[0], r3[1]); o.y = pk2(r3[2], r3[3]); o.z = pk2(r3[4], r3[5]); o.w = pk2(r3[6], r3[7]); *(LAS v4u*)(qk + (3 * 64 + s) * 136 + dg * 8) = o; }
    __syncthreads();
    LAS bf16* vT = (LAS bf16*)lds;
    LAS bf16* Am = (LAS bf16*)(lds + 18432);
    LAS float* part = (LAS float*)(lds + 27648);
#pragma unroll
    for (int it = 0; it < 2; ++it) { const int s = tid & 63, dg = (tid >> 6) + 8 * it;
        const v4u vw = *(const v4u*)(Z + (size_t)(m0 + s) * ZW + ZGV + h * 128 + dg * 8);
#pragma unroll
        for (int e = 0; e < 8; ++e) { const unsigned vwd = vw[e >> 1]; vT[(dg * 8 + e) * 72 + s] = (bf16)((e & 1) ? (vwd >> 16) : (vwd & 0xffffu)); } }
    const int fr = lane & 15, fq = lane >> 4;
#pragma unroll
    for (int bi = 0; bi < 2; ++bi) { const int blk = wave * 2 + bi, ib = blk >> 2, sb = blk & 3;
        f32x4 af_ = {0.f, 0.f, 0.f, 0.f}, ab_ = {0.f, 0.f, 0.f, 0.f};
#pragma unroll
        for (int ks = 0; ks < 4; ++ks) {
            const bf16x8 q0 = *(const LAS bf16x8*)(qk + (0 * 64 + ib * 16 + fr) * 136 + ks * 32 + fq * 8), k0 = *(const LAS bf16x8*)(qk + (1 * 64 + sb * 16 + fr) * 136 + ks * 32 + fq * 8);
            const bf16x8 q1 = *(const LAS bf16x8*)(qk + (2 * 64 + ib * 16 + fr) * 136 + ks * 32 + fq * 8), k1 = *(const LAS bf16x8*)(qk + (3 * 64 + sb * 16 + fr) * 136 + ks * 32 + fq * 8);
            af_ = MFMA16(q0, k0, af_); ab_ = MFMA16(q1, k1, ab_); }
#pragma unroll
        for (int j = 0; j < 4; ++j) { const int i = ib * 16 + 4 * fq + j, s = sb * 16 + fr; const float val = (s <= i ? af_[j] : 0.f) + (s >= i ? ab_[j] : 0.f); Am[i * 72 + s] = (bf16)f2bf(val); } }
    __syncthreads();
    const int ib = wave & 3, dvh = wave >> 2; const int combo0 = (b * 4 + h) * 2;
    const bf16* Sf = (const bf16*)A.out + ((size_t)(combo0 + 0) * 64 + n) * 16384; const bf16* Sb = (const bf16*)A.out + ((size_t)(combo0 + 1) * 64 + n) * 16384;
    bf16x8 bam[2], bqf[4], bqb[4];
#pragma unroll
    for (int ks = 0; ks < 2; ++ks) bam[ks] = *(const LAS bf16x8*)(Am + (ib * 16 + fr) * 72 + ks * 32 + fq * 8);
#pragma unroll
    for (int ks = 0; ks < 4; ++ks) { bqf[ks] = *(const LAS bf16x8*)(qk + (0 * 64 + ib * 16 + fr) * 136 + ks * 32 + fq * 8); bqb[ks] = *(const LAS bf16x8*)(qk + (2 * 64 + ib * 16 + fr) * 136 + ks * 32 + fq * 8); }
    f32x4 o[4]; float ss = 0.f;
#pragma unroll
    for (int dvi = 0; dvi < 4; ++dvi) { const int dvb = dvh * 4 + dvi; f32x4 acc = {0.f, 0.f, 0.f, 0.f};
#pragma unroll
        for (int ks = 0; ks < 2; ++ks) { const bf16x8 a = *(const LAS bf16x8*)(vT + (dvb * 16 + fr) * 72 + ks * 32 + fq * 8); acc = MFMA16(a, bam[ks], acc); }
#pragma unroll
        for (int ks = 0; ks < 4; ++ks) { const bf16x8 a = *(const bf16x8*)(Sf + (size_t)(dvb * 16 + fr) * 128 + ks * 32 + fq * 8); acc = MFMA16(a, bqf[ks], acc); }
#pragma unroll
        for (int ks = 0; ks < 4; ++ks) { const bf16x8 a = *(const bf16x8*)(Sb + (size_t)(dvb * 16 + fr) * 128 + ks * 32 + fq * 8); acc = MFMA16(a, bqb[ks], acc); }
        o[dvi] = acc; ss += (acc[0] * acc[0] + acc[1] * acc[1]) + (acc[2] * acc[2] + acc[3] * acc[3]); }
    ss += __shfl_xor(ss, 16); ss += __shfl_xor(ss, 32);
    if (fq == 0) part[dvh * 64 + ib * 16 + fr] = ss;
    __syncthreads();
    const float rstd = __builtin_amdgcn_rsqf((part[ib * 16 + fr] + part[64 + ib * 16 + fr]) * (1.f / 128.f) + EPS);
    const int row = m0 + ib * 16 + fr; const float* ng = A.in[14]; bf16* Y = (bf16*)(A.ws + WS_Y);
#pragma unroll
    for (int dvi = 0; dvi < 4; ++dvi) { const int dv0 = (dvh * 4 + dvi) * 16 + 4 * fq; const f32x4 g = *(const f32x4*)(ng + dv0);
        const v2u rw = *(const v2u*)(Z + (size_t)row * ZW + ZGR + h * 128 + dv0);
        const float r0 = lo16(rw.x), r1 = hi16(rw.x), r2 = lo16(rw.y), r3 = hi16(rw.y);
        const float y0 = o[dvi][0] * rstd * g[0] * (r0 * sigmoidf_(r0)), y1 = o[dvi][1] * rstd * g[1] * (r1 * sigmoidf_(r1)), y2 = o[dvi][2] * rstd * g[2] * (r2 * sigmoidf_(r2)), y3 = o[dvi][3] * rstd * g[3] * (r3 * sigmoidf_(r3));
        v2u w; w.x = pk2(y0, y1); w.y = pk2(y2, y3); *(v2u*)(Y + (size_t)row * 512 + h * 128 + dv0) = w; }
    __syncthreads();
}

constexpr int AT_STAGE = 22528, AT_VOFF = 13312, AT_NT = LK / 64;
constexpr float AT_THR = 8.f;
DI void attn_qk(f32x4 (&st)[4][2], const LAS unsigned char* Kt, const bf16x8 (&qf)[2][3], float nm0, float nm1, int fr, int fq) {
#pragma unroll
    for (int kb = 0; kb < 4; ++kb) { st[kb][0] = (f32x4){nm0, nm0, nm0, nm0}; st[kb][1] = (f32x4){nm1, nm1, nm1, nm1};
#pragma unroll
        for (int ks = 0; ks < 3; ++ks) { const bf16x8 kf = *(const LAS bf16x8*)(Kt + (kb * 16 + fr) * 208 + ks * 64 + fq * 16);
            st[kb][0] = MFMA16(kf, qf[0][ks], st[kb][0]); st[kb][1] = MFMA16(kf, qf[1][ks], st[kb][1]); } }
}
DI void attn_unit(const Args& A, LAS unsigned char* lds, int u, int tid, int wave, int lane, bool dry) {
    const int bh = u >> 4, qb = u & 15, b = bh >> 3, h = bh & 7, fr = lane & 15, fq = lane >> 4;
    bf16* Qn = (bf16*)(A.ws + WS_QN); const bf16* Qr = (const bf16*)(A.ws + WS_QR);
    const bf16* Kn = (const bf16*)(A.ws + WS_KN) + (size_t)bh * LK * 64; const bf16* Kr = (const bf16*)(A.ws + WS_KR) + (size_t)b * LK * 32; const bf16* VT = (const bf16*)(A.ws + WS_VT) + (size_t)bh * 64 * LK;
    bf16x8 qf[2][3];
#pragma unroll
    for (int qq = 0; qq < 2; ++qq) { const size_t row = (size_t)b * SEQ + qb * 256 + wave * 32 + qq * 16 + fr;
        qf[qq][0] = *(const bf16x8*)(Qn + row * 512 + h * 64 + fq * 8); qf[qq][1] = *(const bf16x8*)(Qn + row * 512 + h * 64 + 32 + fq * 8); qf[qq][2] = *(const bf16x8*)(Qr + row * 256 + h * 32 + fq * 8); }
    f32x4 oacc[4][2];
#pragma unroll
    for (int i = 0; i < 4; ++i)
#pragma unroll
        for (int qq = 0; qq < 2; ++qq) oacc[i][qq] = (f32x4){0.f, 0.f, 0.f, 0.f};
    float mrun[2] = {0.f, 0.f};
    f32x4 lacc[2] = {{0.f, 0.f, 0.f, 0.f}, {0.f, 0.f, 0.f, 0.f}};
    const unsigned one2_ = (fr == 0) ? 0x3f803f80u : 0u; const v4u ones4_ = {one2_, one2_, one2_, one2_}; const bf16x8 vones = __builtin_bit_cast(bf16x8, ones4_);
    const int kkey = tid >> 3, kch = tid & 7, rkey = (tid >> 2) & 63, rch = tid & 3;
    v4u kreg, rreg = {0u, 0u, 0u, 0u}, vreg;
#define ATT_GLOAD(t) do { const int key0_ = (t) * 64; kreg = *(const v4u*)(Kn + (size_t)(key0_ + kkey) * 64 + kch * 8); if (tid < 256) rreg = *(const v4u*)(Kr + (size_t)(key0_ + rkey) * 32 + rch * 8); \
        vreg = *(const v4u*)(VT + (size_t)kkey * LK + key0_ + kch * 8); } while (0)
#define ATT_LSTORE(st_) do { LAS unsigned char* base_ = lds + (st_) * AT_STAGE; *(LAS v4u*)(base_ + kkey * 208 + kch * 16) = kreg; if (tid < 256) *(LAS v4u*)(base_ + rkey * 208 + 128 + rch * 16) = rreg; \
        *(LAS v4u*)(base_ + AT_VOFF + kkey * 144 + kch * 16) = vreg; } while (0)
#define ATT_STEP(T, CUR, NXT) do { \
        const int t_ = (T); const int sc_ = t_ % 3, sn_ = (t_ + 1) % 3, sl_ = (t_ + 2) % 3; \
        if (t_ + 2 < AT_NT) ATT_GLOAD(t_ + 2); \
        if (t_ + 1 < AT_NT) attn_qk(NXT, lds + sn_ * AT_STAGE, qf, -mrun[0], -mrun[1], fr, fq); \
        float mx_[2]; \
        _Pragma("unroll") for (int qq = 0; qq < 2; ++qq) { \
            float m_ = fmaxf(fmaxf(CUR[0][qq][0], CUR[0][qq][1]), fmaxf(CUR[0][qq][2], CUR[0][qq][3])); \
            _Pragma("unroll") for (int kb = 1; kb < 4; ++kb) m_ = fmaxf(m_, fmaxf(fmaxf(CUR[kb][qq][0], CUR[kb][qq][1]), fmaxf(CUR[kb][qq][2], CUR[kb][qq][3]))); \
            m_ = fmaxf(m_, __shfl_xor(m_, 16)); m_ = fmaxf(m_, __shfl_xor(m_, 32)); mx_[qq] = m_; } \
        if (__any((t_ == 0) || (mx_[0] > AT_THR) || (mx_[1] > AT_THR))) { \
            _Pragma("unroll") for (int qq = 0; qq < 2; ++qq) { const float dl_ = (t_ == 0) ? mx_[qq] : fmaxf(mx_[qq], 0.f), sf_ = (t_ == 0) ? 1.f : __builtin_amdgcn_exp2f(-dl_);     \
                mrun[qq] += dl_; lacc[qq] = lacc[qq] * sf_; \
                _Pragma("unroll") for (int kb = 0; kb < 4; ++kb) { CUR[kb][qq] = CUR[kb][qq] - dl_; NXT[kb][qq] = NXT[kb][qq] - dl_; oacc[kb][qq] = oacc[kb][qq] * sf_; } } } \
        bf16x8 pf_[2][2]; \
        _Pragma("unroll") for (int qq = 0; qq < 2; ++qq) { \
            _Pragma("unroll") for (int kb = 0; kb < 4; ++kb) _Pragma("unroll") for (int j = 0; j < 4; ++j) CUR[kb][qq][j] = __builtin_amdgcn_exp2f(CUR[kb][qq][j]); \
            _Pragma("unroll") for (int k2 = 0; k2 < 2; ++k2) pf_[k2][qq] = __builtin_bit_cast(bf16x8, pack8(CUR[2 * k2][qq], CUR[2 * k2 + 1][qq])); } \
        const LAS unsigned char* Vt_ = lds + sc_ * AT_STAGE + AT_VOFF; \
        _Pragma("unroll") for (int k2 = 0; k2 < 2; ++k2) { lacc[0] = MFMA16(vones, pf_[k2][0], lacc[0]); lacc[1] = MFMA16(vones, pf_[k2][1], lacc[1]); } \
        _Pragma("unroll") for (int dvb = 0; dvb < 4; ++dvb) _Pragma("unroll") for (int k2 = 0; k2 < 2; ++k2) { const LAS unsigned char* vp_ = Vt_ + (dvb * 16 + fr) * 144 + (k2 * 32 + 4 * fq) * 2; \
            const v2u lo_ = *(const LAS v2u*)vp_, hi_ = *(const LAS v2u*)(vp_ + 32); v4u vv_; vv_.x = lo_.x; vv_.y = lo_.y; vv_.z = hi_.x; vv_.w = hi_.y; const bf16x8 vf_ = __builtin_bit_cast(bf16x8, vv_); \
            oacc[dvb][0] = MFMA16(vf_, pf_[k2][0], oacc[dvb][0]); oacc[dvb][1] = MFMA16(vf_, pf_[k2][1], oacc[dvb][1]); } \
        if (t_ + 2 < AT_NT) ATT_LSTORE(sl_); \
        __syncthreads(); } while (0)
    ATT_GLOAD(0); ATT_LSTORE(0); ATT_GLOAD(1); ATT_LSTORE(1); __syncthreads();
    f32x4 sta[4][2], stb[4][2];
    attn_qk(sta, lds, qf, 0.f, 0.f, fr, fq);
#pragma unroll
    for (int kb = 0; kb < 4; ++kb) { stb[kb][0] = (f32x4){0.f, 0.f, 0.f, 0.f}; stb[kb][1] = (f32x4){0.f, 0.f, 0.f, 0.f}; }
    for (int t = 0; t < AT_NT; t += 2) { ATT_STEP(t, sta, stb); ATT_STEP(t + 1, stb, sta); }
    if (!dry)
#pragma unroll
    for (int qq = 0; qq < 2; ++qq) { const float l = __shfl(lacc[qq][0], fr); const float inv = 1.f / l;
        const size_t row = (size_t)b * SEQ + qb * 256 + wave * 32 + qq * 16 + fr;
#pragma unroll
        for (int dvb = 0; dvb < 4; ++dvb) { const f32x4 o = oacc[dvb][qq] * inv; v2u w; w.x = pk2(o[0], o[1]); w.y = pk2(o[2], o[3]); *(v2u*)(Qn + row * 512 + h * 64 + dvb * 16 + 4 * fq) = w; } }
#undef ATT_STEP
#undef ATT_GLOAD
#undef ATT_LSTORE
}

DI float gelu1(float v) {
    const float av = fabsf(v), t = __builtin_amdgcn_rcpf(av * 0.2316418882f + 1.0f);
    float q = t * 0.5307027145f + (-0.7265760135f); q = q * t + 0.7107068705f; q = q * t + (-0.142248368f); q = q * t + 0.127414796f; q = q * t;
    const float e = __builtin_amdgcn_exp2f((v * v) * (-0.72134752044f)); const float m = v * (q * e);
    return v < 0.f ? m : v - m;
}
DI f32x2 up2(unsigned w) { return (f32x2){lo16(w), hi16(w)}; }
DI f32x2 gelu_pk(f32x2 v) {
    const f32x2 av = __builtin_elementwise_abs(v), d = av * 0.2316418882f + 1.0f;
    f32x2 t; t.x = __builtin_amdgcn_rcpf(d.x); t.y = __builtin_amdgcn_rcpf(d.y);
    f32x2 q = t * 0.5307027145f + (-0.7265760135f); q = q * t + 0.7107068705f; q = q * t + (-0.142248368f); q = q * t + 0.127414796f; q = q * t;
    const f32x2 s = (v * v) * (-0.72134752044f);
    f32x2 e; e.x = __builtin_amdgcn_exp2f(s.x); e.y = __builtin_amdgcn_exp2f(s.y);
    const f32x2 m = v * (q * e), r = v - m;
    f32x2 o; o.x = v.x < 0.f ? m.x : r.x; o.y = v.y < 0.f ? m.y : r.y; return o;
}
DI void conv_phase(const Args& A, int tid, bool dry) {
    bf16* VG = (bf16*)(A.ws + WS_Z); const bf16* cw = (const bf16*)(A.ws + WS_CONVW); const float* cb = A.in[21];
    const int gt = blockIdx.x * 512 + tid, GT = gridDim.x * 512;
    const v4u zero4 = {0u, 0u, 0u, 0u};
    for (int item = gt; item < NBATCH * 64 * 2 * 352; item += GT) {
        const int cgp = item % 352, rest = item / 352, half = rest & 1, r = (rest >> 1) & 63, b = rest >> 7, c0 = half * 32;
        f32x2 w[9][4];
#pragma unroll
        for (int tap = 0; tap < 9; ++tap) { const v4u ww = *(const v4u*)(cw + tap * FF + cgp * 8); w[tap][0] = up2(ww.x); w[tap][1] = up2(ww.y); w[tap][2] = up2(ww.z); w[tap][3] = up2(ww.w); }
        f32x2 bias[4]; { const f32x4 b0 = *(const f32x4*)(cb + cgp * 8), b1 = *(const f32x4*)(cb + cgp * 8 + 4); bias[0] = (f32x2){b0[0], b0[1]}; bias[1] = (f32x2){b0[2], b0[3]}; bias[2] = (f32x2){b1[0], b1[1]}; bias[3] = (f32x2){b1[2], b1[3]}; }
        const size_t m0 = (size_t)b * SEQ + r * 64;
        const bf16* gb = VG + FF + cgp * 8; bf16* vb = VG + cgp * 8;
        const bool ok0 = r > 0, ok2 = r < 63;
        v4u g[3][4];
#define CLOAD(dy, ok, c) (((ok) && (c) >= 0 && (c) < 64) ? *(const v4u*)(gb + (m0 + ((dy) - 1) * 64 + (c)) * FF2) : zero4)
        g[0][0] = zero4; g[1][0] = zero4; g[2][0] = zero4;
        g[0][1] = CLOAD(0, ok0, c0 - 1); g[1][1] = CLOAD(1, true, c0 - 1); g[2][1] = CLOAD(2, ok2, c0 - 1);
        g[0][2] = CLOAD(0, ok0, c0); g[1][2] = CLOAD(1, true, c0); g[2][2] = CLOAD(2, ok2, c0);
        g[0][3] = CLOAD(0, ok0, c0 + 1); g[1][3] = CLOAD(1, true, c0 + 1); g[2][3] = CLOAD(2, ok2, c0 + 1);
        v4u vnext = *(const v4u*)(vb + (m0 + c0) * FF2);
#pragma unroll 2
        for (int c = c0; c < c0 + 32; ++c) {
#pragma unroll
            for (int dy = 0; dy < 3; ++dy) { g[dy][0] = g[dy][1]; g[dy][1] = g[dy][2]; g[dy][2] = g[dy][3]; }
            g[0][3] = CLOAD(0, ok0, c + 2); g[1][3] = CLOAD(1, true, c + 2); g[2][3] = CLOAD(2, ok2, c + 2);
            const v4u vv = vnext; if (c + 1 < c0 + 32) vnext = *(const v4u*)(vb + (m0 + c + 1) * FF2);
            f32x2 acc[4] = {bias[0], bias[1], bias[2], bias[3]};
#pragma unroll
            for (int dy = 0; dy < 3; ++dy)
#pragma unroll
                for (int dx = 0; dx < 3; ++dx) { const v4u gg = g[dy][dx];
                    acc[0] += up2(gg.x) * w[dy * 3 + dx][0]; acc[1] += up2(gg.y) * w[dy * 3 + dx][1]; acc[2] += up2(gg.z) * w[dy * 3 + dx][2]; acc[3] += up2(gg.w) * w[dy * 3 + dx][3]; }
            const f32x2 o0 = gelu_pk(acc[0]) * up2(vv.x), o1 = gelu_pk(acc[1]) * up2(vv.y), o2 = gelu_pk(acc[2]) * up2(vv.z), o3 = gelu_pk(acc[3]) * up2(vv.w);
            v4u o; o.x = pk2(o0.x, o0.y); o.y = pk2(o1.x, o1.y); o.z = pk2(o2.x, o2.y); o.w = pk2(o3.x, o3.y);
            if (!dry) *(v4u*)(vb + (m0 + c) * FF2) = o;
        }
#undef CLOAD
    }
}

#define RLX_AGENT __ATOMIC_RELAXED, __HIP_MEMORY_SCOPE_AGENT
#define XB_TMO      128
#define XB_XCNT(j)  (256  + 64 * (j))
#define XB_XSUB(j)  (1280 + 64 * (j))
#define XB_XGEN(j)  (2304 + 64 * (j))
#define XB_TOP      3328
#define XB_TOPGEN   3392
#define XCD_BAR_WORDS 3456
#define XB_SPIN_CAP (1u << 18)

__device__ __forceinline__ unsigned xb_ld(unsigned* p)              { return __hip_atomic_load(p, __ATOMIC_RELAXED, __HIP_MEMORY_SCOPE_AGENT); }
__device__ __forceinline__ unsigned xb_add(unsigned* p, unsigned v) { return __hip_atomic_fetch_add(p, v, __ATOMIC_RELAXED, __HIP_MEMORY_SCOPE_AGENT); }
__device__ __forceinline__ unsigned xb_xcc_id() { return (unsigned)__builtin_amdgcn_s_getreg((3 << 11) | 20) & 0xFu; }
#define XB_SPIN(cond, bar) do { unsigned _sp = 0; while (cond) { __builtin_amdgcn_s_sleep(1); \
    if ((++_sp & 255u) == 0u) { if (xb_ld(&(bar)[XB_TMO])) break; if (_sp > XB_SPIN_CAP) { atomicAdd(&(bar)[XB_TMO], 1u); break; } } } } while (0)

struct XcdBarrier {
    unsigned* bar; unsigned x;
    volatile LAS unsigned* st;
};

__device__ __forceinline__ XcdBarrier xcd_barrier_post(unsigned* bar, volatile LAS unsigned* st) {
    XcdBarrier b; b.bar = bar; b.x = xb_xcc_id(); b.st = st;
    if (threadIdx.x == 0) (void)xb_add(&bar[XB_XCNT(b.x)], 1u);
    return b;
}
__device__ __forceinline__ void xcd_barrier_complete(unsigned* bar, unsigned x, unsigned& nloc, unsigned& nx) {
    const unsigned G = gridDim.x * gridDim.y * gridDim.z;
    unsigned sum, cnt, mine, sp = 0u;
    for (;;) {
        sum = 0u; cnt = 0u; mine = 0u;
#pragma unroll
        for (unsigned j = 0; j < 16; ++j) { const unsigned c = xb_ld(&bar[XB_XCNT(j)]); sum += c; cnt += (c > 0u) ? 1u : 0u; mine = (j == x) ? c : mine; }
        if (sum == G) break;
        __builtin_amdgcn_s_sleep(1);
        if ((++sp & 255u) == 0u) { if (xb_ld(&bar[XB_TMO])) break; if (sp > XB_SPIN_CAP) { atomicAdd(&bar[XB_TMO], 1u); break; } }
    }
    nloc = mine > 0u ? mine : 1u; nx = cnt > 0u ? cnt : 1u;
}

__device__ __forceinline__ void xcd_barrier(const XcdBarrier& b) {
    asm volatile("s_waitcnt vmcnt(0)" ::: "memory");
    __syncthreads();
    if (threadIdx.x == 0) {
        unsigned* bar = b.bar;
        __builtin_amdgcn_s_waitcnt(0);
        unsigned nloc = b.st[0], nx = b.st[1];
        if (nloc == 0u) { xcd_barrier_complete(bar, b.x, nloc, nx); b.st[0] = nloc; b.st[1] = nx; }
        const unsigned old = xb_add(&bar[XB_XSUB(b.x)], 1u);
        const unsigned gen = old / nloc;
        if (old + 1u == (gen + 1u) * nloc) {
            __builtin_amdgcn_fence(__ATOMIC_RELEASE, "agent");
            asm volatile("s_waitcnt vmcnt(0)" ::: "memory");
            const unsigned og = xb_add(&bar[XB_TOP], 1u);
            const unsigned tg = og / nx;
            if (og + 1u == (tg + 1u) * nx) xb_add(&bar[XB_TOPGEN], 1u);
            else XB_SPIN(xb_ld(&bar[XB_TOPGEN]) == tg, bar);
            __builtin_amdgcn_fence(__ATOMIC_ACQUIRE, "agent");
            xb_add(&bar[XB_XGEN(b.x)], 1u);
            asm volatile("s_waitcnt vmcnt(0)" ::: "memory");
        } else {
            XB_SPIN(xb_ld(&bar[XB_XGEN(b.x)]) == gen, bar);
            __builtin_amdgcn_fence(__ATOMIC_ACQUIRE, "agent");
            asm volatile("s_waitcnt vmcnt(0)" ::: "memory");
        }
    }
    __syncthreads();
}

#ifndef MK_DUP
#define MK_DUP 0
#endif
constexpr int LDS_BYTES = 147456;
constexpr int NPHASE = 13;
__global__ void __launch_bounds__(512, 2) mk_fwd(Args args) {
    extern __shared__ __attribute__((aligned(16))) unsigned char lds_raw[];
    LAS unsigned char* lds = (LAS unsigned char*)lds_raw;
    cg::grid_group grid = cg::this_grid();
    const int tid = threadIdx.x, lane = tid & 63, wave = __builtin_amdgcn_readfirstlane(tid >> 6);
    const int lo = args.ph_lo, hi = args.ph_hi;
    unsigned char* ws = args.ws;
    const int gw = blockIdx.x * 8 + wave, NGW = gridDim.x * 8;
    float* mod = (float*)(ws + WS_MOD);
#define IN(k) (lo <= (k) && (k) < hi)
    volatile LAS unsigned* bst = (volatile LAS unsigned*)(lds + LDS_BYTES - 64);
    if (tid < 2) bst[tid] = 0u;
    __syncthreads();
    XcdBarrier xbar = xcd_barrier_post((unsigned*)(ws + WS_BAR), bst);
    if (args.dup == 0x7fffffff) grid.sync();
#define SEAM(k) do { if (IN(k) && IN((k) + 1)) xcd_barrier(xbar); } while (0)
#define REP(bit) for (int rep_ = ((MK_DUP >> (bit)) & 1) ? 0 : 1; rep_ < 2; ++rep_)
#define DRY (rep_ == 0 && args.dup != 0)
    if (IN(0)) REP(0) { for (int it = blockIdx.x; it < 96; it += gridDim.x) p0_mod(args, (LAS float*)lds, tid, wave, lane, it); }
    SEAM(0);
    if (IN(1)) REP(1) {
        bf16* H = (bf16*)(ws + WS_H);
        for (int row = gw; row < MA; row += 2 * NGW) { const int r1 = row + NGW; const bool two = r1 < MA;
            const int b0 = row < ML ? (row >> 12) : 8, b1 = two ? (r1 < ML ? (r1 >> 12) : 8) : b0;
            const float* x0 = row < ML ? args.in[0] + (size_t)row * 1024 : args.in[2] + (size_t)(row - ML) * 1024;
            const float* x1 = two ? (r1 < ML ? args.in[0] + (size_t)r1 * 1024 : args.in[2] + (size_t)(r1 - ML) * 1024) : nullptr;
            rownorm_mod2(x0, x1, args.in[6], mod + b0 * 6144, mod + b0 * 6144 + 1024, mod + b1 * 6144, mod + b1 * 6144 + 1024, H + (size_t)row * 1024, H + (size_t)r1 * 1024, lane); }
        p0_transposes(args, lds, tid, wave, lane);
    }
    SEAM(1);
    if (IN(2)) run_inproj(lds, args);
    SEAM(2);
    if (IN(3)) {
        if ((MK_DUP >> 3) & 1) { run_gemm(lds, args, -args.dup, (const bf16*)(ws + WS_Z) + ZQ, ZW, (const bf16*)(ws + WS_WUQ), ML, 768, 384);
            run_gemm(lds, args, -args.dup, (const bf16*)(ws + WS_Z) + ZKV, ZW, (const bf16*)(ws + WS_WUKV), MA, 1024, 256); ropek_phase(args, tid); }
        run_gemm(lds, args, 2, (const bf16*)(ws + WS_Z) + ZQ, ZW, (const bf16*)(ws + WS_WUQ), ML, 768, 384);
        run_gemm(lds, args, 3, (const bf16*)(ws + WS_Z) + ZKV, ZW, (const bf16*)(ws + WS_WUKV), MA, 1024, 256);
        ropek_phase(args, tid);
        bias2_phase(args, wave, lane);
        REP(4) for (int u = (int)gridDim.x - 1 - (int)blockIdx.x; u < 2176; u += gridDim.x) gla_a_unit(args, lds, u, tid, wave, lane);
    }
    SEAM(3);
    if (IN(4)) {
        REP(5) gla_scan(args, tid, DRY);
        REP(6) for (int u = blockIdx.x; u < 1024; u += gridDim.x) attn_unit(args, lds, u, tid, wave, lane, DRY);
    }
    SEAM(4);
    if (IN(5)) {
        REP(7) for (int u = blockIdx.x; u < 2048; u += gridDim.x) gla_c_unit(args, lds, u, tid, wave, lane);
        { if ((MK_DUP >> 8) & 1) run_gemm(lds, args, -args.dup, (const bf16*)(ws + WS_QN), 512, (const bf16*)(ws + WS_WBRM), ML, 1024, 512); run_gemm(lds, args, 4, (const bf16*)(ws + WS_QN), 512, (const bf16*)(ws + WS_WBRM), ML, 1024, 512); }
    }
    SEAM(5);
    if (IN(6)) { if ((MK_DUP >> 9) & 1) run_gemm(lds, args, -args.dup, (const bf16*)(ws + WS_Y), 512, (const bf16*)(ws + WS_WBRG), ML, 1024, 512); run_gemm(lds, args, 5, (const bf16*)(ws + WS_Y), 512, (const bf16*)(ws + WS_WBRG), ML, 1024, 512); }
    SEAM(6);
    if (IN(7)) { if ((MK_DUP >> 10) & 1) run_gemm(lds, args, -args.dup, (const bf16*)(ws + WS_T1), 1024, (const bf16*)(ws + WS_WOUT), ML, 1024, 1024); run_gemm(lds, args, 6, (const bf16*)(ws + WS_T1), 1024, (const bf16*)(ws + WS_WOUT), ML, 1024, 1024); }
    SEAM(7);
    if (IN(9)) { if ((MK_DUP >> 12) & 1) run_gemm(lds, args, 1, (const bf16*)(ws + WS_H), 1024, (const bf16*)(ws + WS_WUP), ML, FF2, 1024); run_gemm(lds, args, 1, (const bf16*)(ws + WS_H), 1024, (const bf16*)(ws + WS_WUP), ML, FF2, 1024); }
    SEAM(9);
    if (IN(10)) REP(13) conv_phase(args, tid, DRY);
    SEAM(10);
    if (IN(11)) { if ((MK_DUP >> 14) & 1) run_gemm(lds, args, -args.dup, (const bf16*)(ws + WS_Z), FF2, (const bf16*)(ws + WS_WDOWN), ML, 1024, FF); run_gemm(lds, args, 7, (const bf16*)(ws + WS_Z), FF2, (const bf16*)(ws + WS_WDOWN), ML, 1024, FF); }
    if ((MK_DUP >> 16) & 1) { for (int i = 0; i < 10; ++i) xcd_barrier(xbar); }
    SEAM(11);
    if (IN(12)) {
        const float* fg = args.in[23];
        for (int row = gw; row < ML; row += 2 * NGW) { const int r1 = (row + NGW < ML) ? row + NGW : row;
            f32x4* xr0 = (f32x4*)(args.out + (size_t)row * 1024) + lane; f32x4* xr1 = (f32x4*)(args.out + (size_t)r1 * 1024) + lane; f32x4 v0[4], v1[4]; float s0 = 0.f, s1 = 0.f;
#pragma unroll
            for (int j = 0; j < 4; ++j) { v0[j] = xr0[64 * j]; v1[j] = xr1[64 * j]; }
#pragma unroll
            for (int j = 0; j < 4; ++j) { s0 += (v0[j].x * v0[j].x + v0[j].y * v0[j].y) + (v0[j].z * v0[j].z + v0[j].w * v0[j].w); s1 += (v1[j].x * v1[j].x + v1[j].y * v1[j].y) + (v1[j].z * v1[j].z + v1[j].w * v1[j].w); }
#pragma unroll
            for (int o = 1; o < 64; o <<= 1) { s0 += __shfl_xor(s0, o); s1 += __shfl_xor(s1, o); }
            const float q0 = __builtin_amdgcn_rsqf(s0 * (1.f / 1024.f) + EPS), q1 = __builtin_amdgcn_rsqf(s1 * (1.f / 1024.f) + EPS);
#pragma unroll
            for (int j = 0; j < 4; ++j) { const f32x4 gg = ((const f32x4*)fg)[lane + 64 * j]; xr0[64 * j] = v0[j] * q0 * gg; if (r1 != row) xr1[64 * j] = v1[j] * q1 * gg; } }
    }
#undef REP
#undef DRY
#undef IN
#undef SEAM
}

#ifndef MK_SPLIT
#define MK_SPLIT 0
#endif
extern "C" void kernel_launch(void* const* d_in, const int* in_sizes, int n_in, void* d_out, int out_size, void* d_ws, size_t ws_size, hipStream_t stream) {
    static int grid = 0;
    if (grid == 0) {
        if (n_in != 24 || out_size != ML * DM || ws_size < WS_END) { fprintf(stderr, "kernel_launch: unexpected shapes (n_in %d out %d ws %zu)\n", n_in, out_size, ws_size); grid = -1; return; }
        int dev = 0, cus = 0, per_cu = 0;
        hipGetDevice(&dev); hipDeviceGetAttribute(&cus, hipDeviceAttributeMultiprocessorCount, dev);
        if (hipFuncSetAttribute((const void*)mk_fwd, hipFuncAttributeMaxDynamicSharedMemorySize, LDS_BYTES) != hipSuccess) { fprintf(stderr, "kernel_launch: hipFuncSetAttribute failed\n"); grid = -1; return; }
        if (hipOccupancyMaxActiveBlocksPerMultiprocessor(&per_cu, (const void*)mk_fwd, 512, LDS_BYTES) != hipSuccess || per_cu < 1) { fprintf(stderr, "kernel_launch: occupancy query says %d\n", per_cu); per_cu = 1; }
        (void)hipGetLastError();
        grid = cus * 1;
        fprintf(stderr, "kernel_launch: grid %d (cus %d per_cu %d)\n", grid, cus, per_cu);
    }
    if (grid < 0) return;
    hipMemsetAsync((char*)d_ws, 0, WS_ZERO_BYTES, stream);
    Args a{};
    for (int i = 0; i < 24; ++i) a.in[i] = (const float*)d_in[i];
    a.out = (float*)d_out; a.ws = (unsigned char*)d_ws;
#if MK_SPLIT
    for (int ph = 0; ph < NPHASE; ++ph) { a.ph_lo = ph; a.ph_hi = ph + 1; void* kargs[] = {&a};
        hipError_t e = hipLaunchCooperativeKernel((const void*)mk_fwd, dim3(grid), dim3(512), kargs, LDS_BYTES, stream);
        if (e != hipSuccess) { fprintf(stderr, "cooperative launch failed (phase %d): %s\n", ph, hipGetErrorString(e)); break; } }
#else
    a.ph_lo = 0; a.ph_hi = NPHASE; a.dup = 1; void* kargs[] = {&a};
    hipError_t e = hipLaunchCooperativeKernel((const void*)mk_fwd, dim3(grid), dim3(512), kargs, LDS_BYTES, stream);
    if (e != hipSuccess) fprintf(stderr, "cooperative launch failed: %s (grid %d)\n", hipGetErrorString(e), grid);
#endif
}
```

```cpp
#include <hip/hip_runtime.h>
#include <hip/hip_cooperative_groups.h>
#include <cstdio>
#include <cstdint>
namespace cg = cooperative_groups;
namespace pg8 {
#define PG8_LAS __attribute__((address_space(3)))
typedef unsigned short bf16_t;
typedef short bf16x8 __attribute__((ext_vector_type(8)));
typedef float f32x4 __attribute__((ext_vector_type(4)));
typedef unsigned u32x4 __attribute__((ext_vector_type(4)));
constexpr int BM = 256, BK = 64, HALF = 128, HTB = HALF * BK * 2  , STAGE_BYTES = 8 * HTB, NXCD = 8, WGM = 8;

__host__ __device__ __forceinline__ int lds_byte(int r, int c) { const int st = (r >> 4) * 2 + (c >> 5), rr = r & 15, cc = c & 31, ob = rr * 64 + cc * 2; return st * 1024 + (ob ^ (((ob >> 9) & 1) << 5)); }
__host__ __device__ __forceinline__ void stage_rc(int b, int& R, int& C) { const int st = b / 1024, sb = b % 1024, swz = sb ^ (((sb >> 9) & 1) << 5); R = (st >> 1) * 16 + swz / 64; C = (st & 1) * 32 + (swz % 64) / 2; }
__host__ __device__ __forceinline__ int perm32(int rho) { const int n = rho >> 4, i = rho & 15; return 8 * (i >> 2) + 4 * n + (i & 3); }

struct Unit { int pm, pn; };
struct Gemm { const bf16_t* A; const bf16_t* Bt; int M, N, K, lda; };

struct StaticOrder {
    int nM, nN, nwg, G, c;
    __host__ __device__ void init(int M, int N, int G_, int c_) { nM = M / BM; nN = N / BM; nwg = nM * nN; G = G_; c = c_; }
    __host__ __device__ bool next(int i, Unit& u) const {
        const long L = (long)i * G + c; if (L >= nwg) return false;
        int wgid = (int)L; { const int q = nwg / NXCD, r = nwg % NXCD, xcd = wgid % NXCD, off = wgid / NXCD; wgid = (xcd < r ? xcd * (q + 1) : r * (q + 1) + (xcd - r) * q) + off; }
        const int nig = WGM * nN, gid = wgid / nig, fm = gid * WGM, gsz = (nM - fm) < WGM ? (nM - fm) : WGM;
        u.pm = fm + ((wgid % nig) % gsz); u.pn = (wgid % nig) / gsz; return true;
    }
    __device__ __forceinline__ void a_ready(const Unit&) const {}
    __device__ __forceinline__ void done(const Unit&) const {}
};


template <class Epi, class Sched, bool ALIGN_EPI = false, bool SP2 = false>
__device__ __forceinline__ void gemm_phase(PG8_LAS unsigned char* lds, const Gemm g, const Sched& S, const Epi& E) {
    const int tid = threadIdx.x, wid = __builtin_amdgcn_readfirstlane(tid >> 6), lane = tid & 63, wr = wid >> 2, wc = wid & 3, fr = lane & 15, fq = lane >> 4;
    const int K = g.K, nt = K / BK;
    unsigned voffA[2], voffB[2];
#pragma unroll
    for (int i = 0; i < 2; ++i) { int R, C; stage_rc(tid * 16 + i * 8192, R, C); const int Rb = Epi::PERM ? ((R & ~31) + perm32(R & 31)) : R;
        voffA[i] = (unsigned)(R * g.lda + C) * 2u; voffB[i] = (unsigned)(Rb * K + C) * 2u; }
    const size_t kstep = (size_t)(BK * 2);
    const size_t hstep = (size_t)HALF * K * 2;
    const size_t tstep = 2 * hstep; const size_t hstepA = (size_t)HALF * g.lda * 2, tstepA = 2 * hstepA;
    const unsigned ldsw = (unsigned)wid * 1024u;
    const int aoff = lds_byte(wr * 64 + fr, fq * 8), boff = lds_byte(wc * 32 + fr, fq * 8);
#define PG8_SA(b, h) (((b) * 2 + (h)) * HTB)
#define PG8_SB(b, h) ((4 + (b) * 2 + (h)) * HTB)
#define PG8_STAGE(bufoff, gbase, voff) do { _Pragma("unroll") for (int _i = 0; _i < 2; ++_i) \
        __builtin_amdgcn_global_load_lds((const unsigned*)((const char*)(gbase) + (voff)[_i]), (PG8_LAS unsigned*)(lds + (bufoff) + ldsw + _i * 8192), 16, 0, 0); } while (0)
#define PG8_LDA(dst, b, h) do { _Pragma("unroll") for (int m = 0; m < 4; ++m) _Pragma("unroll") for (int k = 0; k < 2; ++k) dst[m][k] = *(const PG8_LAS bf16x8*)(lds + PG8_SA(b, h) + aoff + m * 2048 + k * 1024); } while (0)
#define PG8_LDB(dst, b, h) do { _Pragma("unroll") for (int n = 0; n < 2; ++n) _Pragma("unroll") for (int k = 0; k < 2; ++k) dst[n][k] = *(const PG8_LAS bf16x8*)(lds + PG8_SB(b, h) + boff + n * 2048 + k * 1024); } while (0)
#define PG8_MMA(ai, bj, At, Bt) do { __builtin_amdgcn_s_setprio(1); _Pragma("unroll") for (int m = 0; m < 4; ++m) _Pragma("unroll") for (int n = 0; n < 2; ++n) _Pragma("unroll") for (int k = 0; k < 2; ++k) \
        acc[ai][bj][m][n] = __builtin_amdgcn_mfma_f32_16x16x32_bf16(Bt[n][k], At[m][k], acc[ai][bj][m][n], 0, 0, 0); __builtin_amdgcn_s_setprio(0); } while (0)
#define PG8_WAIT_V(n) asm volatile("s_waitcnt vmcnt(" #n ")" ::: "memory")
#define PG8_WAIT_L(n) asm volatile("s_waitcnt lgkmcnt(" #n ")" ::: "memory")
#define PG8_BAR __builtin_amdgcn_s_barrier()
#define PG8_SCHED __builtin_amdgcn_sched_barrier(0)
    Unit cur, nxt; int ui = 0;
    if (!S.next(0, cur)) return;
    f32x4 acc[2][2][4][2];
#pragma unroll
    for (int a = 0; a < 2; ++a)
#pragma unroll
        for (int b = 0; b < 2; ++b)
#pragma unroll
            for (int m = 0; m < 4; ++m)
#pragma unroll
                for (int n = 0; n < 2; ++n) acc[a][b][m][n] = (f32x4){0.f, 0.f, 0.f, 0.f};
    bf16x8 At[4][2], B0[2][2], B1[2][2];
    const char* cA = (const char*)g.A + (size_t)cur.pm * tstepA; const char* cB = (const char*)g.Bt + (size_t)cur.pn * tstep;
    S.a_ready(cur);
    if constexpr (SP2) {
        PG8_STAGE(PG8_SB(0, 0), cB, voffB); PG8_STAGE(PG8_SB(0, 1), cB + hstep, voffB); PG8_STAGE(PG8_SA(0, 0), cA, voffA); PG8_STAGE(PG8_SA(0, 1), cA + hstepA, voffA);
        if (wr == 1) PG8_BAR;
        PG8_WAIT_V(2); PG8_BAR;
        PG8_STAGE(PG8_SB(1, 0), cB + kstep, voffB); PG8_STAGE(PG8_SA(1, 0), cA + kstep, voffA); PG8_STAGE(PG8_SB(1, 1), cB + hstep + kstep, voffB);
        PG8_WAIT_V(6); PG8_BAR;
    } else {
        PG8_STAGE(PG8_SB(0, 0), cB, voffB); PG8_STAGE(PG8_SA(0, 0), cA, voffA); PG8_STAGE(PG8_SB(0, 1), cB + hstep, voffB); PG8_STAGE(PG8_SA(0, 1), cA + hstepA, voffA);
        if (wr == 1) PG8_BAR;
        PG8_WAIT_V(4); PG8_BAR;
        PG8_STAGE(PG8_SB(1, 0), cB + kstep, voffB); PG8_STAGE(PG8_SA(1, 0), cA + kstep, voffA); PG8_STAGE(PG8_SB(1, 1), cB + hstep + kstep, voffB);
        PG8_WAIT_V(6); PG8_BAR;
    }
    for (;;) {
        const bool has_next = S.next(ui + 1, nxt);
        const char* nA = has_next ? (const char*)g.A + (size_t)nxt.pm * tstepA : cA; const char* nB = has_next ? (const char*)g.Bt + (size_t)nxt.pn * tstep : cB;
        for (int t = 0; t < nt; t += 2) {
            const bool last = (t == nt - 2);
            const char* a1 = cA + (size_t)(t + 1) * kstep;
            const char* a2 = last ? nA : cA + (size_t)(t + 2) * kstep; const char* b2 = last ? nB : cB + (size_t)(t + 2) * kstep;
            const char* a3 = a2 + kstep; const char* b3 = b2 + kstep;
            if (last && has_next) S.a_ready(nxt);
            if constexpr (SP2) {
            PG8_LDB(B0, 0, 0); PG8_LDB(B1, 0, 1); PG8_SCHED; PG8_LDA(At, 0, 0); PG8_STAGE(PG8_SA(1, 1), a1 + hstepA, voffA);
            PG8_WAIT_V(8); PG8_WAIT_L(0); PG8_BAR; PG8_MMA(0, 0, At, B0); PG8_MMA(0, 1, At, B1); PG8_BAR; PG8_SCHED;
            PG8_LDA(At, 0, 1); PG8_STAGE(PG8_SB(0, 0), b2, voffB); PG8_STAGE(PG8_SB(0, 1), b2 + hstep, voffB); PG8_STAGE(PG8_SA(0, 0), a2, voffA);
            PG8_WAIT_V(8); PG8_WAIT_L(0); PG8_BAR; PG8_MMA(1, 0, At, B0); PG8_MMA(1, 1, At, B1); PG8_BAR; PG8_SCHED;
            PG8_LDB(B0, 1, 0); PG8_LDB(B1, 1, 1); PG8_SCHED; PG8_LDA(At, 1, 0); PG8_STAGE(PG8_SA(0, 1), a2 + hstepA, voffA);
            PG8_WAIT_V(8); PG8_WAIT_L(0); PG8_BAR; PG8_MMA(0, 0, At, B0); PG8_MMA(0, 1, At, B1); PG8_BAR; PG8_SCHED;
            PG8_LDA(At, 1, 1); PG8_STAGE(PG8_SB(1, 0), b3, voffB); PG8_STAGE(PG8_SB(1, 1), b3 + hstep, voffB); PG8_STAGE(PG8_SA(1, 0), a3, voffA);
            PG8_WAIT_V(8); PG8_WAIT_L(0); PG8_BAR; PG8_MMA(1, 0, At, B0); PG8_MMA(1, 1, At, B1); PG8_BAR; PG8_SCHED;
            } else {
            PG8_LDB(B0, 0, 0); PG8_SCHED; PG8_LDA(At, 0, 0); PG8_STAGE(PG8_SA(1, 1), a1 + hstepA, voffA);
            PG8_WAIT_L(8); PG8_BAR; PG8_WAIT_L(0); PG8_MMA(0, 0, At, B0); PG8_BAR; PG8_SCHED;
            PG8_LDB(B1, 0, 1); PG8_STAGE(PG8_SB(0, 0), b2, voffB);
            PG8_BAR; PG8_WAIT_L(0); PG8_MMA(0, 1, At, B1); PG8_BAR;
            PG8_LDA(At, 0, 1); PG8_STAGE(PG8_SA(0, 0), a2, voffA);
            PG8_BAR; PG8_WAIT_L(0); PG8_MMA(1, 0, At, B0); PG8_BAR; PG8_SCHED;
            PG8_STAGE(PG8_SB(0, 1), b2 + hstep, voffB);
            PG8_WAIT_V(6); PG8_BAR; PG8_MMA(1, 1, At, B1); PG8_BAR;
            PG8_LDB(B0, 1, 0); PG8_SCHED; PG8_LDA(At, 1, 0); PG8_STAGE(PG8_SA(0, 1), a2 + hstepA, voffA);
            PG8_WAIT_L(8); PG8_BAR; PG8_WAIT_L(0); PG8_MMA(0, 0, At, B0); PG8_BAR; PG8_SCHED;
            PG8_LDB(B1, 1, 1); PG8_STAGE(PG8_SB(1, 0), b3, voffB);
            PG8_BAR; PG8_WAIT_L(0); PG8_MMA(0, 1, At, B1); PG8_BAR;
            PG8_LDA(At, 1, 1); PG8_STAGE(PG8_SA(1, 0), a3, voffA);
            PG8_BAR; PG8_WAIT_L(0); PG8_MMA(1, 0, At, B0); PG8_BAR; PG8_SCHED;
            PG8_STAGE(PG8_SB(1, 1), b3 + hstep, voffB);
            PG8_WAIT_V(6); PG8_BAR; PG8_MMA(1, 1, At, B1); PG8_BAR;
            }
        }
        if constexpr (ALIGN_EPI) { if (wr == 0) PG8_BAR; }
        if constexpr (!Epi::AFTER_DRAIN) { E(acc, cur, wr, wc, fr, fq); S.done(cur); }
        if (!has_next) break;
#pragma unroll
        for (int a = 0; a < 2; ++a)
#pragma unroll
            for (int b = 0; b < 2; ++b)
#pragma unroll
                for (int m = 0; m < 4; ++m)
#pragma unroll
                    for (int n = 0; n < 2; ++n) acc[a][b][m][n] = (f32x4){0.f, 0.f, 0.f, 0.f};
        cur = nxt; cA = nA; cB = nB; ++ui;
        if constexpr (ALIGN_EPI) { if (wr == 1) PG8_BAR; }
    }
    PG8_WAIT_V(0);
    if constexpr (!ALIGN_EPI) { if (wr == 0) PG8_BAR; }
    PG8_BAR;
    if constexpr (Epi::AFTER_DRAIN) { E.fused(acc, cur, wr, wc, fr, fq, lds, wid, lane); S.done(cur); }
#undef PG8_SA
#undef PG8_SB
#undef PG8_STAGE
#undef PG8_LDA
#undef PG8_LDB
#undef PG8_MMA
#undef PG8_WAIT_V
#undef PG8_WAIT_L
#undef PG8_BAR
#undef PG8_SCHED
}
}
#define DI __device__ __forceinline__
#define LAS __attribute__((address_space(3)))
typedef unsigned short bf16;
typedef unsigned v4u __attribute__((ext_vector_type(4)));
typedef unsigned v2u __attribute__((ext_vector_type(2)));
typedef float f32x4 __attribute__((ext_vector_type(4)));
typedef float f32x2 __attribute__((ext_vector_type(2)));
typedef short bf16x8 __attribute__((ext_vector_type(8)));
typedef short s16x4 __attribute__((ext_vector_type(4)));

constexpr int DM = 1024, NBATCH = 8, SEQ = 4096, CTX = 256;
constexpr int ML = NBATCH * SEQ, MC = NBATCH * CTX, MA = ML + MC;
constexpr int ZW = 4864;
constexpr int ZQ = 0, ZKV = 384, ZKR = 640, ZGQ = 672, ZGK = 1184, ZGV = 1696, ZGR = 2208, ZGL = 2720, ZGM = 2752, ZGG = 3776;
constexpr int LK = SEQ + CTX;
constexpr int FF = 2816, FF2 = 5632;
constexpr float EPS = 1e-6f;
constexpr float QSCALE = 0.10206207261596577f * 1.4426950408889634f;
constexpr float GLA_QSCALE = 0.08838834764831845f;
constexpr size_t MiB = 1u << 20;
constexpr size_t WS_SSQ = 0, WS_SSKV = 256 * 1024, WS_BAR = 416 * 1024, WS_SS2 = 640 * 1024, WS_ZERO_BYTES = 1 * MiB, WS_MOD = 1 * MiB, WS_BIAS2 = 1 * MiB + 256 * 1024;
constexpr size_t WS_WIN = 2 * MiB, WS_WUQ = 12 * MiB, WS_WUKV = 13 * MiB, WS_WBRM = 14 * MiB, WS_WBRG = 15 * MiB, WS_WOUT = 16 * MiB, WS_WUP = 18 * MiB, WS_WDOWN = 29 * MiB, WS_CONVW = 35 * MiB;
constexpr size_t WS_H = 36 * MiB;
constexpr size_t WS_QN = 36 * MiB, WS_QR = 68 * MiB, WS_UCTX = 84 * MiB, WS_DEC = 92 * MiB, WS_Y = 68 * MiB;
constexpr size_t WS_Z = 104 * MiB;
constexpr size_t WS_KN = 427 * MiB, WS_VT = 461 * MiB, WS_KR = 495 * MiB, WS_T1 = 427 * MiB;
constexpr size_t WS_END = 512 * MiB;

struct Args {
    const float* in[24]; float* out; unsigned char* ws; int ph_lo, ph_hi, dup, pad;
};

DI float bf2f(unsigned u) { return __builtin_bit_cast(float, u << 16); }
DI unsigned pk2(float lo, float hi);
DI unsigned f2bf(float f) { return pk2(f, 0.f) & 0xffffu; }
typedef __bf16 bf16x2_t __attribute__((ext_vector_type(2)));
DI unsigned pk2(float lo, float hi) { const f32x2 v = {lo, hi}; const bf16x2_t b = __builtin_convertvector(v, bf16x2_t); return __builtin_bit_cast(unsigned, b); }
DI float lo16(unsigned w) { return __builtin_bit_cast(float, w << 16); }
DI float hi16(unsigned w) { return __builtin_bit_cast(float, w & 0xffff0000u); }
DI float wave_sum(float v) {
#pragma unroll
    for (int o = 1; o < 64; o <<= 1) v += __shfl_xor(v, o);
    return v;
}
DI float sigmoidf_(float x) { return 1.f / (1.f + __expf(-x)); }
DI float rope_invf(int i) { return __builtin_amdgcn_exp2f(-1.6609640474436813f * (float)i); }
DI int rope_perm(int r) { const int a = r >> 4, rr = r & 15, half = rr >> 3, i = rr & 7; return 16 * a + 2 * i + half; }

DI int perm_col(int mode, int n) {
    if (mode == 1) { const int h = n / 96, w = n - 96 * h; return (w >= 64) ? h * 96 + 64 + rope_perm(w - 64) : n; }
    if (mode == 2) { return (n >= ZKR && n < ZKR + 32) ? ZKR + rope_perm(n - ZKR) : n; }
    return n;
}
DI void p0_transpose_item(const float* W, int K, int N, bf16* WT, const float* kscale, int mode, LAS float* scr, int item, int lane) {
    const int nblk = N / 32, kb = item / nblk, nb = item % nblk, k0 = 64 * kb, n0 = 32 * nb;
#pragma unroll 8
    for (int i = 0; i < 32; ++i) { const int kk = 2 * i + (lane >> 5); scr[kk * 33 + (lane & 31)] = W[(size_t)(k0 + kk) * N + n0 + (lane & 31)]; }
    asm volatile("s_waitcnt lgkmcnt(0)" ::: "memory");
    const int c = lane & 7;
    float ks[8];
#pragma unroll
    for (int i = 0; i < 8; ++i) ks[i] = kscale ? kscale[k0 + 8 * c + i] : 1.f;
#pragma unroll
    for (int j = 0; j < 4; ++j) { const int n = (lane >> 3) + 8 * j; const LAS float* s = scr + (8 * c) * 33 + n;
        v4u o; o.x = pk2(s[0 * 33] * ks[0], s[1 * 33] * ks[1]); o.y = pk2(s[2 * 33] * ks[2], s[3 * 33] * ks[3]); o.z = pk2(s[4 * 33] * ks[4], s[5 * 33] * ks[5]); o.w = pk2(s[6 * 33] * ks[6], s[7 * 33] * ks[7]);
        *(v4u*)(WT + (size_t)perm_col(mode, n0 + n) * K + k0 + 8 * c) = o; }
    asm volatile("s_waitcnt lgkmcnt(0)" ::: "memory");
}

DI void p0_mod(const Args& A, LAS float* sc, int tid, int wave, int lane, int blk) {
    const float* c = A.in[1]; const float* cctx = A.in[3]; const float* w_ada = A.in[4]; const float* b_ada = A.in[5];
    float* mod = (float*)(A.ws + WS_MOD);
    for (int i = tid; i < 9 * 1024; i += 512) { const int r = i >> 10, k = i & 1023; const float v = (r < 8) ? c[r * 1024 + k] : cctx[k]; sc[i] = v / (1.f + __expf(-v)); }
    __syncthreads();
    const int col = blk * 64 + lane;
    float acc[9];
#pragma unroll
    for (int r = 0; r < 9; ++r) acc[r] = 0.f;
    for (int k = wave * 128; k < wave * 128 + 128; ++k) { const float w = w_ada[(size_t)k * 6144 + col];
#pragma unroll
        for (int r = 0; r < 9; ++r) acc[r] += sc[r * 1024 + k] * w; }
    LAS float* red = sc + 9 * 1024;
#pragma unroll
    for (int r = 0; r < 9; ++r) red[(wave * 9 + r) * 64 + lane] = acc[r];
    __syncthreads();
    for (int i = tid; i < 9 * 64; i += 512) { const int r = i >> 6, l = i & 63; float s = b_ada[blk * 64 + l];
#pragma unroll
        for (int w = 0; w < 8; ++w) s += red[(w * 9 + r) * 64 + l];
        mod[r * 6144 + blk * 64 + l] = s; }
    __syncthreads();
}

DI void p0_transposes(const Args& A, LAS unsigned char* lds, int tid, int wave, int lane) {
    unsigned char* ws = A.ws;
    LAS float* scr = (LAS float*)(lds + wave * 16384);
    const int gw = blockIdx.x * 8 + wave, NGW = gridDim.x * 8;
    constexpr int I1 = 16 * 150, I2 = 6 * 24, I3 = 4 * 32, I4 = 8 * 32, I5 = 8 * 32, I6 = 16 * 32, I7 = 16 * 176, I8 = 44 * 32;
    constexpr int NITEMS = I1 + I2 + I3 + I4 + I5 + I6 + I7 + I8;
    for (int it = gw; it < NITEMS; it += NGW) {
        int r = it;
        if (r < I1) { p0_transpose_item(A.in[7], 1024, 4800, (bf16*)(ws + WS_WIN), nullptr, 2, scr, r, lane); continue; } r -= I1;
        if (r < I2) { p0_transpose_item(A.in[9], 384, 768, (bf16*)(ws + WS_WUQ), A.in[8], 1, scr, r, lane); continue; } r -= I2;
        if (r < I3) { p0_transpose_item(A.in[11], 256, 1024, (bf16*)(ws + WS_WUKV), A.in[10], 0, scr, r, lane); continue; } r -= I3;
        if (r < I4) { p0_transpose_item(A.in[15], 512, 1024, (bf16*)(ws + WS_WBRM), nullptr, 0, scr, r, lane); continue; } r -= I4;
        if (r < I5) { p0_transpose_item(A.in[16], 512, 1024, (bf16*)(ws + WS_WBRG), nullptr, 0, scr, r, lane); continue; } r -= I5;
        if (r < I6) { p0_transpose_item(A.in[17], 1024, 1024, (bf16*)(ws + WS_WOUT), nullptr, 0, scr, r, lane); continue; } r -= I6;
        if (r < I7) { p0_transpose_item(A.in[19], 1024, 5632, (bf16*)(ws + WS_WUP), nullptr, 0, scr, r, lane); continue; } r -= I7;
        p0_transpose_item(A.in[22], 2816, 1024, (bf16*)(ws + WS_WDOWN), nullptr, 0, scr, r, lane);
    }
    const int gt = blockIdx.x * 512 + tid, GT = gridDim.x * 512;
    for (int i = gt; i < 64 * 1024 / 8; i += GT) *(v4u*)((bf16*)(ws + WS_WIN) + (size_t)4800 * 1024 + (size_t)i * 8) = (v4u){0u, 0u, 0u, 0u};
    for (int i = gt; i < 9 * FF / 2; i += GT) ((unsigned*)(ws + WS_CONVW))[i] = pk2(A.in[20][2 * i], A.in[20][2 * i + 1]);
}

DI void rownorm_fin(const f32x4 (&v)[4], float ssum, const float* g, const float* sh, const float* sc, bf16* orow, int lane) {
    const float rstd = __builtin_amdgcn_rsqf(ssum * (1.f / 1024.f) + EPS);
    v2u* o8 = (v2u*)orow + lane;
#pragma unroll
    for (int j = 0; j < 4; ++j) {
        const f32x4 gg = ((const f32x4*)g)[lane + 64 * j], ss = ((const f32x4*)sc)[lane + 64 * j], hh = ((const f32x4*)sh)[lane + 64 * j];
        const f32x4 y = v[j] * rstd * gg * (ss + 1.f) + hh;
        v2u w; w.x = pk2(y.x, y.y); w.y = pk2(y.z, y.w); o8[64 * j] = w; }
}
DI void rownorm_mod2(const float* x0, const float* x1, const float* g, const float* sh0, const float* sc0, const float* sh1, const float* sc1, bf16* o0, bf16* o1, int lane) {
    const f32x4* xr0 = (const f32x4*)x0 + lane; const f32x4* xr1 = (const f32x4*)(x1 ? x1 : x0) + lane;
    f32x4 v0[4], v1[4]; float s0 = 0.f, s1 = 0.f;
#pragma unroll
    for (int j = 0; j < 4; ++j) { v0[j] = xr0[64 * j]; v1[j] = xr1[64 * j]; }
#pragma unroll
    for (int j = 0; j < 4; ++j) { s0 += (v0[j].x * v0[j].x + v0[j].y * v0[j].y) + (v0[j].z * v0[j].z + v0[j].w * v0[j].w); s1 += (v1[j].x * v1[j].x + v1[j].y * v1[j].y) + (v1[j].z * v1[j].z + v1[j].w * v1[j].w); }
#pragma unroll
    for (int o = 1; o < 64; o <<= 1) { s0 += __shfl_xor(s0, o); s1 += __shfl_xor(s1, o); }
    rownorm_fin(v0, s0, g, sh0, sc0, o0, lane);
    if (x1) rownorm_fin(v1, s1, g, sh1, sc1, o1, lane);
}
typedef const f32x4 (&AccRef)[2][2][4][2];
DI v4u pack8(f32x4 v0, f32x4 v1) { v4u w; w.x = pk2(v0[0], v0[1]); w.y = pk2(v0[2], v0[3]); w.z = pk2(v1[0], v1[1]); w.w = pk2(v1[2], v1[3]); return w; }

DI void epi_bf16(AccRef acc, const pg8::Unit& u, int wr, int wc, int fr, int fq, bf16* O, int ldc) {
    const int row0 = u.pm * 256 + wr * 64 + fr, col0 = u.pn * 256 + wc * 32 + 8 * fq;
#pragma unroll
    for (int ai = 0; ai < 2; ++ai)
#pragma unroll
        for (int m = 0; m < 4; ++m) { bf16* rowp = O + (size_t)(row0 + ai * 128 + m * 16) * ldc + col0;
#pragma unroll
            for (int bj = 0; bj < 2; ++bj) *(v4u*)(rowp + bj * 128) = pack8(acc[ai][bj][m][0], acc[ai][bj][m][1]); }
}
DI void epi_sumsq(AccRef acc, const pg8::Unit& u, int wr, int wc, int fr, int fq, float* ssq, float* sskv) {
    if (u.pn > 2) return;
#pragma unroll
    for (int bj = 0; bj < 2; ++bj) { const int colb = u.pn * 256 + bj * 128; float* dst = colb < 384 ? ssq : (colb < 640 ? sskv : nullptr);
        if (dst) {
#pragma unroll
            for (int ai = 0; ai < 2; ++ai)
#pragma unroll
                for (int m = 0; m < 4; ++m) { const f32x4 a = acc[ai][bj][m][0], b = acc[ai][bj][m][1];
                    float s = (a[0] * a[0] + a[1] * a[1]) + (a[2] * a[2] + a[3] * a[3]) + (b[0] * b[0] + b[1] * b[1]) + (b[2] * b[2] + b[3] * b[3]);
                    s += __shfl_xor(s, 16); s += __shfl_xor(s, 32);
                    if (fq == 0) atomicAdd(dst + (u.pm * 256 + ai * 128 + wr * 64 + m * 16 + fr), s); } } }
}
DI void epi_q(AccRef acc, const pg8::Unit& u, int wr, int wc, int fr, int fq, const float* ssq, bf16* Qn, bf16* Qr) {
#pragma unroll
    for (int ai = 0; ai < 2; ++ai)
#pragma unroll
        for (int m = 0; m < 4; ++m) { const int row = u.pm * 256 + ai * 128 + wr * 64 + m * 16 + fr;
            const float rs = __builtin_amdgcn_rsqf(ssq[row] * (1.f / 384.f) + EPS) * QSCALE; const int t = row & 4095; const float prow = (float)(t >> 6), pcol = (float)(t & 63);
#pragma unroll
            for (int bj = 0; bj < 2; ++bj)
#pragma unroll
                for (int n = 0; n < 2; ++n) { const int col4 = u.pn * 256 + bj * 128 + wc * 32 + 8 * fq + 4 * n, h = col4 / 96, w = col4 - 96 * h; const f32x4 v = acc[ai][bj][m][n] * rs;
                    if (w < 64) { v2u o; o.x = pk2(v[0], v[1]); o.y = pk2(v[2], v[3]); *(v2u*)(Qn + (size_t)row * 512 + h * 64 + w) = o; }
                    else { const int r0 = w - 64, a = r0 >> 4, i0 = (r0 & 15) >> 1; const float pos = a ? pcol : prow;
                        const float a0 = pos * rope_invf(i0), a1 = pos * rope_invf(i0 + 1); const float c0 = __cosf(a0), s0 = __sinf(a0), c1 = __cosf(a1), s1 = __sinf(a1);
                        v2u o; o.x = pk2(v[0] * c0 - v[1] * s0, v[1] * c0 + v[0] * s0); o.y = pk2(v[2] * c1 - v[3] * s1, v[3] * c1 + v[2] * s1);
                        *(v2u*)(Qr + (size_t)row * 256 + h * 32 + r0) = o; } } }
}
DI void epi_kv(AccRef acc, const pg8::Unit& u, int wr, int wc, int fr, int fq, const float* sskv, bf16* Kn, bf16* VT) {
#pragma unroll
    for (int ai = 0; ai < 2; ++ai)
#pragma unroll
        for (int m = 0; m < 4; ++m) { const int row = u.pm * 256 + ai * 128 + wr * 64 + m * 16 + fr;
            const float rs = __builtin_amdgcn_rsqf(sskv[row] * (1.f / 256.f) + EPS);
            int b, key; if (row < ML) { b = row >> 12; key = row & 4095; } else { const int r = row - ML; b = r >> 8; key = SEQ + (r & 255); }
#pragma unroll
            for (int bj = 0; bj < 2; ++bj) { const int h = u.pn * 2 + bj; const f32x4 v0 = acc[ai][bj][m][0] * rs, v1 = acc[ai][bj][m][1] * rs;
                if (wc < 2) { *(v4u*)(Kn + ((size_t)(b * 8 + h) * LK + key) * 64 + wc * 32 + 8 * fq) = pack8(v0, v1); }
                else { bf16* p = VT + ((size_t)(b * 8 + h) * 64 + (wc - 2) * 32 + 8 * fq) * LK + key;
                    p[0] = (bf16)f2bf(v0[0]); p[LK] = (bf16)f2bf(v0[1]); p[2 * LK] = (bf16)f2bf(v0[2]); p[3 * LK] = (bf16)f2bf(v0[3]);
                    p[4 * LK] = (bf16)f2bf(v1[0]); p[5 * LK] = (bf16)f2bf(v1[1]); p[6 * LK] = (bf16)f2bf(v1[2]); p[7 * LK] = (bf16)f2bf(v1[3]); } } }
}
DI void epi_t1(AccRef acc, const pg8::Unit& u, int wr, int wc, int fr, int fq, const bf16* Z, bf16* T1, bool second) {
    const int goff = second ? ZGG : ZGM;
#pragma unroll
    for (int ai = 0; ai < 2; ++ai)
#pragma unroll
        for (int m = 0; m < 4; ++m) { const int row = u.pm * 256 + ai * 128 + wr * 64 + m * 16 + fr;
#pragma unroll
            for (int bj = 0; bj < 2; ++bj) { const int col8 = u.pn * 256 + bj * 128 + wc * 32 + 8 * fq;
                const v4u g = *(const v4u*)(Z + (size_t)row * ZW + goff + col8);
                f32x4 v0 = acc[ai][bj][m][0], v1 = acc[ai][bj][m][1];
                v0[0] *= sigmoidf_(lo16(g.x)); v0[1] *= sigmoidf_(hi16(g.x)); v0[2] *= sigmoidf_(lo16(g.y)); v0[3] *= sigmoidf_(hi16(g.y));
                v1[0] *= sigmoidf_(lo16(g.z)); v1[1] *= sigmoidf_(hi16(g.z)); v1[2] *= sigmoidf_(lo16(g.w)); v1[3] *= sigmoidf_(hi16(g.w));
                bf16* dst = T1 + (size_t)row * 1024 + col8;
                if (second) { const v4u t = *(const v4u*)dst;
                    v0[0] += lo16(t.x); v0[1] += hi16(t.x); v0[2] += lo16(t.y); v0[3] += hi16(t.y); v1[0] += lo16(t.z); v1[1] += hi16(t.z); v1[2] += lo16(t.w); v1[3] += hi16(t.w); }
                *(v4u*)dst = pack8(v0, v1); } }
}
DI void epi_res(AccRef acc, const pg8::Unit& u, int wr, int wc, int fr, int fq, const float* base, const float* gate, float* dst) {
#pragma unroll
    for (int ai = 0; ai < 2; ++ai)
#pragma unroll
        for (int m = 0; m < 4; ++m) { const int row = u.pm * 256 + ai * 128 + wr * 64 + m * 16 + fr; const float* gp = gate + (size_t)(row >> 12) * 6144;
#pragma unroll
            for (int bj = 0; bj < 2; ++bj)
#pragma unroll
                for (int n = 0; n < 2; ++n) { const int col4 = u.pn * 256 + bj * 128 + wc * 32 + 8 * fq + 4 * n;
                    const f32x4 xb = *(const f32x4*)(base + (size_t)row * 1024 + col4), gg = *(const f32x4*)(gp + col4);
                    *(f32x4*)(dst + (size_t)row * 1024 + col4) = xb + gg * acc[ai][bj][m][n]; } }
}
DI void epi_x1(AccRef acc, const pg8::Unit& u, int wr, int wc, int fr, int fq, const float* x, const float* mod, float* dst, const float* g2, bf16* H2, float* ss2) {
    const float* mb = mod + (size_t)((u.pm * 256) >> 12) * 6144;
    f32x4 gt[2][2], gm[2][2];
#pragma unroll
    for (int bj = 0; bj < 2; ++bj)
#pragma unroll
        for (int n = 0; n < 2; ++n) { const int col4 = u.pn * 256 + bj * 128 + wc * 32 + 8 * fq + 4 * n;
            gt[bj][n] = *(const f32x4*)(mb + 2048 + col4); gm[bj][n] = *(const f32x4*)(g2 + col4) * (*(const f32x4*)(mb + 4096 + col4) + 1.f); }
#pragma unroll
    for (int ai = 0; ai < 2; ++ai)
#pragma unroll
        for (int m = 0; m < 4; ++m) { const int row = u.pm * 256 + ai * 128 + wr * 64 + m * 16 + fr; float ssum = 0.f;
#pragma unroll
            for (int bj = 0; bj < 2; ++bj) { const int col8 = u.pn * 256 + bj * 128 + wc * 32 + 8 * fq;
                const f32x4 x0 = *(const f32x4*)(x + (size_t)row * 1024 + col8) + gt[bj][0] * acc[ai][bj][m][0], x1 = *(const f32x4*)(x + (size_t)row * 1024 + col8 + 4) + gt[bj][1] * acc[ai][bj][m][1];
                *(f32x4*)(dst + (size_t)row * 1024 + col8) = x0; *(f32x4*)(dst + (size_t)row * 1024 + col8 + 4) = x1;
                ssum += (x0[0] * x0[0] + x0[1] * x0[1]) + (x0[2] * x0[2] + x0[3] * x0[3]) + (x1[0] * x1[0] + x1[1] * x1[1]) + (x1[2] * x1[2] + x1[3] * x1[3]);
                *(v4u*)(H2 + (size_t)row * 1024 + col8) = pack8(x0 * gm[bj][0], x1 * gm[bj][1]); }
            ssum += __shfl_xor(ssum, 16); ssum += __shfl_xor(ssum, 32);
            if (fq == 0) atomicAdd(ss2 + row, ssum); }
}
DI void epi_up(AccRef acc, const pg8::Unit& u, int wr, int wc, int fr, int fq, bf16* VG, const float* ss2, const float* bias2) {
    const float* bb = bias2 + (size_t)((u.pm * 256) >> 12) * FF2;
    f32x4 bv[2][2];
#pragma unroll
    for (int bj = 0; bj < 2; ++bj)
#pragma unroll
        for (int n = 0; n < 2; ++n) bv[bj][n] = *(const f32x4*)(bb + u.pn * 256 + bj * 128 + wc * 32 + 8 * fq + 4 * n);
#pragma unroll
    for (int ai = 0; ai < 2; ++ai)
#pragma unroll
        for (int m = 0; m < 4; ++m) { const int row = u.pm * 256 + ai * 128 + wr * 64 + m * 16 + fr; const float rs = __builtin_amdgcn_rsqf(ss2[row] * (1.f / 1024.f) + EPS);
            bf16* rowp = VG + (size_t)row * FF2 + u.pn * 256 + wc * 32 + 8 * fq;
#pragma unroll
            for (int bj = 0; bj < 2; ++bj) *(v4u*)(rowp + bj * 128) = pack8(acc[ai][bj][m][0] * rs + bv[bj][0], acc[ai][bj][m][1] * rs + bv[bj][1]); }
}
DI void bias2_phase(const Args& A, int wave, int lane) {
    const bf16* Wup = (const bf16*)(A.ws + WS_WUP); const float* mod = (const float*)(A.ws + WS_MOD); float* b2 = (float*)(A.ws + WS_BIAS2);
    for (int n = blockIdx.x * 8 + wave; n < FF2; n += gridDim.x * 8) {
        const v4u w0 = *(const v4u*)(Wup + (size_t)n * 1024 + lane * 16), w1 = *(const v4u*)(Wup + (size_t)n * 1024 + lane * 16 + 8);
        const f32x4 wa = {lo16(w0.x), hi16(w0.x), lo16(w0.y), hi16(w0.y)}, wb = {lo16(w0.z), hi16(w0.z), lo16(w0.w), hi16(w0.w)}, wc_ = {lo16(w1.x), hi16(w1.x), lo16(w1.y), hi16(w1.y)}, wd = {lo16(w1.z), hi16(w1.z), lo16(w1.w), hi16(w1.w)};
#pragma unroll
        for (int b = 0; b < NBATCH; ++b) { const f32x4* sh = (const f32x4*)(mod + (size_t)b * 6144 + 3072 + lane * 16);
            const f32x4 p = sh[0] * wa + sh[1] * wb + sh[2] * wc_ + sh[3] * wd; const float t = wave_sum((p[0] + p[1]) + (p[2] + p[3]));
            if (lane == 0) b2[(size_t)b * FF2 + n] = t; }
    }
}
namespace pg8 {
struct EpiAll {
    static constexpr bool PERM = true, AFTER_DRAIN = false;
    int mode; unsigned char* ws; const float* x; float* out; const float* g2;
    __device__ __forceinline__ void operator()(const f32x4 (&acc)[2][2][4][2], const Unit& u, int wr, int wc, int fr, int fq) const {
        float* mod = (float*)(ws + WS_MOD);
        if (mode < 0) return;
        switch (mode) {
        case 0: epi_bf16(acc, u, wr, wc, fr, fq, (bf16*)(ws + WS_Z), ZW); epi_sumsq(acc, u, wr, wc, fr, fq, (float*)(ws + WS_SSQ), (float*)(ws + WS_SSKV)); break;
        case 1: epi_up(acc, u, wr, wc, fr, fq, (bf16*)(ws + WS_Z), (const float*)(ws + WS_SS2), (const float*)(ws + WS_BIAS2)); break;
        case 2: epi_q(acc, u, wr, wc, fr, fq, (const float*)(ws + WS_SSQ), (bf16*)(ws + WS_QN), (bf16*)(ws + WS_QR)); break;
        case 3: epi_kv(acc, u, wr, wc, fr, fq, (const float*)(ws + WS_SSKV), (bf16*)(ws + WS_KN), (bf16*)(ws + WS_VT)); break;
        case 4: epi_t1(acc, u, wr, wc, fr, fq, (const bf16*)(ws + WS_Z), (bf16*)(ws + WS_T1), false); break;
        case 5: epi_t1(acc, u, wr, wc, fr, fq, (const bf16*)(ws + WS_Z), (bf16*)(ws + WS_T1), true); break;
        case 6: epi_x1(acc, u, wr, wc, fr, fq, x, mod, out, g2, (bf16*)(ws + WS_H), (float*)(ws + WS_SS2)); break;
        default: epi_res(acc, u, wr, wc, fr, fq, out, mod + 5120, out); break;
        }
    }
};
}

struct InProjOrder {
    pg8::StaticOrder base; int G, c;
    __device__ void init(int G_, int c_) { base.init(ML, ZW, G_, c_); G = G_; c = c_; }
    __device__ bool next(int i, pg8::Unit& u) const {
        const long L = (long)i * G + c;
        if (L < 128 * 19) return base.next(i, u);
        const int k = (int)L - 128 * 19; if (k >= 64) return false;
        const int j = k >> 3; u.pm = 128 + (k & 7); u.pn = j < 2 ? j + 1 : (j < 7 ? j + 2 : 10); return true;
    }
    __device__ __forceinline__ void a_ready(const pg8::Unit&) const {}
    __device__ __forceinline__ void done(const pg8::Unit&) const {}
};
DI void run_inproj(LAS unsigned char* lds, const Args& A) {
    pg8::Gemm g{(const bf16*)(A.ws + WS_H), (const bf16*)(A.ws + WS_WIN), MA, ZW, 1024, 1024}; InProjOrder S; S.init((int)gridDim.x, (int)blockIdx.x);
    pg8::EpiAll E{0, A.ws, A.in[0], A.out, A.in[18]};
    pg8::gemm_phase<pg8::EpiAll, InProjOrder, true, true>(lds, g, S, E);
}
DI void run_gemm(LAS unsigned char* lds, const Args& A, int mode, const bf16* Am, int lda, const bf16* Bt, int M, int N, int K) {
    pg8::Gemm g{Am, Bt, M, N, K, lda}; pg8::StaticOrder S; S.init(M, N, (int)gridDim.x, (int)blockIdx.x);
    pg8::EpiAll E{mode, A.ws, A.in[0], A.out, A.in[18]};
    pg8::gemm_phase<pg8::EpiAll, pg8::StaticOrder, true, true>(lds, g, S, E);
}

DI void ropek_phase(const Args& A, int tid) {
    const bf16* Z = (const bf16*)(A.ws + WS_Z); bf16* Kr = (bf16*)(A.ws + WS_KR);
    const int gt = blockIdx.x * 512 + tid, GT = gridDim.x * 512;
    for (int idx = gt; idx < MA * 8; idx += GT) { const int row = idx >> 3, g = idx & 7;
        const v2u w = *(const v2u*)(Z + (size_t)row * ZW + ZKR + 4 * g);
        float v0 = lo16(w.x), v1 = hi16(w.x), v2 = lo16(w.y), v3 = hi16(w.y);
        int b, key;
        if (row < ML) { b = row >> 12; key = row & 4095; const int r0 = 4 * g, a = r0 >> 4, i0 = (r0 & 15) >> 1; const float pos = a ? (float)(key & 63) : (float)(key >> 6);
            const float a0 = pos * rope_invf(i0), a1 = pos * rope_invf(i0 + 1); const float c0 = __cosf(a0), s0 = __sinf(a0), c1 = __cosf(a1), s1 = __sinf(a1);
            const float y0 = v0 * c0 - v1 * s0, y1 = v1 * c0 + v0 * s0, y2 = v2 * c1 - v3 * s1, y3 = v3 * c1 + v2 * s1; v0 = y0; v1 = y1; v2 = y2; v3 = y3; }
        else { const int r = row - ML; b = r >> 8; key = SEQ + (r & 255); }
        v2u o; o.x = pk2(v0, v1); o.y = pk2(v2, v3); *(v2u*)(Kr + ((size_t)b * LK + key) * 32 + 4 * g) = o; }
}

#define MFMA16(a, b, c) __builtin_amdgcn_mfma_f32_16x16x32_bf16((a), (b), (c), 0, 0, 0)
DI float logsig(float x) { return fminf(x, 0.f) - __logf(1.f + __expf(-fabsf(x))); }
constexpr int GP = 129;
constexpr int GL_GBUF = 0, GL_BLAST = 2 * 64 * GP * 4, GL_Y = 75776;
DI void gla_gates(LAS unsigned char* lds, const bf16* Z, int m0, int h, const float* wdec, const float* bdec, int tid, int wave, int lane) {
    LAS float* gbuf = (LAS float*)(lds + GL_GBUF); LAS float* blast = (LAS float*)(lds + GL_BLAST);
    {
        const int fr = lane & 15, fq = lane >> 4, dir = wave >> 2;
        bf16x8 af[4];
#pragma unroll
        for (int tb = 0; tb < 4; ++tb) af[tb] = *(const bf16x8*)(Z + (size_t)(m0 + tb * 16 + fr) * ZW + ZGL + fq * 8);
#pragma unroll
        for (int i = 0; i < 2; ++i) { const int d = ((wave & 3) * 2 + i) * 16 + fr;
            v4u bw = {0u, 0u, 0u, 0u};
            if ((fq >> 1) == dir) { const float* wp = wdec + (size_t)(dir * 16 + (fq & 1) * 8) * 512 + h * 128 + d;
                bw.x = pk2(wp[0], wp[512]); bw.y = pk2(wp[2 * 512], wp[3 * 512]); bw.z = pk2(wp[4 * 512], wp[5 * 512]); bw.w = pk2(wp[6 * 512], wp[7 * 512]); }
            const bf16x8 bfrag = __builtin_bit_cast(bf16x8, bw); const float bias = bdec[dir * 512 + h * 128 + d];
#pragma unroll
            for (int tb = 0; tb < 4; ++tb) { f32x4 acc = {0.f, 0.f, 0.f, 0.f}; acc = MFMA16(af[tb], bfrag, acc);
#pragma unroll
                for (int j = 0; j < 4; ++j) gbuf[(dir * 64 + tb * 16 + 4 * fq + j) * GP + d] = logsig(acc[j] + bias) * (1.f / 16.f); } }
    }
    __syncthreads();
    {
        const int d = tid & 127, dir = (tid >> 7) & 1, hf = tid >> 8; LAS float* g = gbuf + dir * (64 * GP) + d; LAS float* tot = blast + 256;
        float v[32];
#pragma unroll
        for (int i = 0; i < 32; ++i) v[i] = g[(hf * 32 + i) * GP];
        if (dir == 0) {
#pragma unroll
            for (int i = 1; i < 32; ++i) v[i] += v[i - 1];
            tot[(hf * 2 + dir) * 128 + d] = v[31];
        } else {
#pragma unroll
            for (int i = 30; i >= 0; --i) v[i] += v[i + 1];
            tot[(hf * 2 + dir) * 128 + d] = v[0];
        }
        __syncthreads();
        const float other = tot[((1 - hf) * 2 + dir) * 128 + d];
        const float add = (dir == 0) ? (hf == 1 ? other : 0.f) : (hf == 0 ? other : 0.f);
#pragma unroll
        for (int i = 0; i < 32; ++i) g[(hf * 32 + i) * GP] = v[i] + add;
        if (hf == 0) blast[dir * 128 + d] = ((dir == 0) ? other : v[0]) + ((dir == 0) ? v[31] : other);
    }
    __syncthreads();
}

DI void gla_a_unit(const Args& A, LAS unsigned char* lds, int u, int tid, int wave, int lane) {
    const bf16* Z = (const bf16*)(A.ws + WS_Z);
    int b, h, n, m0; const bool isctx = u >= 2048;
    if (!isctx) { b = u >> 8; h = (u >> 6) & 3; n = u & 63; m0 = b * SEQ + n * 64; } else { const int uc = u - 2048; b = uc >> 4; h = (uc >> 2) & 3; n = uc & 3; m0 = ML + b * CTX + n * 64; }
    gla_gates(lds, Z, m0, h, A.in[12], A.in[13], tid, wave, lane);
    LAS float* gbuf = (LAS float*)(lds + GL_GBUF); LAS float* blast = (LAS float*)(lds + GL_BLAST);
    LAS bf16* kdT = (LAS bf16*)(lds + GL_Y);
    LAS bf16* vT = (LAS bf16*)(lds + GL_Y + 36864);
    const int combo0 = (b * 4 + h) * 2;
    if (tid < 256) { const int dir = tid >> 7, d = tid & 127; ((float*)(A.ws + WS_DEC))[((size_t)(combo0 + dir) * 68 + (isctx ? n : 4 + n)) * 128 + d] = __expf(blast[dir * 128 + d]); }
#pragma unroll
    for (int it = 0; it < 2; ++it) { const int s = tid & 63, dg = (tid >> 6) + 8 * it;
        const v4u kw = *(const v4u*)(Z + (size_t)(m0 + s) * ZW + ZGK + h * 128 + dg * 8), vw = *(const v4u*)(Z + (size_t)(m0 + s) * ZW + ZGV + h * 128 + dg * 8);
#pragma unroll
        for (int e = 0; e < 8; ++e) { const int d = dg * 8 + e; const unsigned kwd = kw[e >> 1], vwd = vw[e >> 1]; const float kf = (e & 1) ? hi16(kwd) : lo16(kwd);
            const float ef = __expf(blast[d] - gbuf[s * GP + d]), eb = __expf(blast[128 + d] - gbuf[(64 + s) * GP + d]);
            kdT[d * 72 + s] = (bf16)f2bf(kf * ef); kdT[(128 + d) * 72 + s] = (bf16)f2bf(kf * eb); vT[d * 72 + s] = (bf16)((e & 1) ? (vwd >> 16) : (vwd & 0xffffu)); } }
    __syncthreads();
    const int fr = lane & 15, fq = lane >> 4, dir = wave >> 2, dkb0 = (wave & 3) * 2;
    bf16x8 af[2][2];
#pragma unroll
    for (int i = 0; i < 2; ++i)
#pragma unroll
        for (int ks = 0; ks < 2; ++ks) af[i][ks] = *(const LAS bf16x8*)(kdT + (dir * 128 + (dkb0 + i) * 16 + fr) * 72 + ks * 32 + fq * 8);
    bf16* dst = isctx ? (bf16*)(A.ws + WS_UCTX) + ((size_t)(combo0 + dir) * 4 + n) * 16384 : (bf16*)A.out + ((size_t)(combo0 + dir) * 64 + n) * 16384;
#pragma unroll 2
    for (int dvb = 0; dvb < 8; ++dvb) { const bf16x8 b0 = *(const LAS bf16x8*)(vT + (dvb * 16 + fr) * 72 + fq * 8), b1 = *(const LAS bf16x8*)(vT + (dvb * 16 + fr) * 72 + 32 + fq * 8);
#pragma unroll
        for (int i = 0; i < 2; ++i) { f32x4 acc = {0.f, 0.f, 0.f, 0.f}; acc = MFMA16(af[i][0], b0, acc); acc = MFMA16(af[i][1], b1, acc);
            v2u o; o.x = pk2(acc[0], acc[1]); o.y = pk2(acc[2], acc[3]); *(v2u*)(dst + (size_t)(dvb * 16 + fr) * 128 + (dkb0 + i) * 16 + 4 * fq) = o; } }
    __syncthreads();
}

DI void gla_scan(const Args& A, int tid, bool dry) {
    bf16* S = (bf16*)A.out; const bf16* Uctx = (const bf16*)(A.ws + WS_UCTX); const float* DEC = (const float*)(A.ws + WS_DEC);
    for (int item = blockIdx.x * 512 + tid; item < 64 * 2048; item += gridDim.x * 512) {
        const int combo = item >> 11, e = (item & 2047) * 8, dk0 = e & 127, dir = combo & 1;
        float s[8];
#pragma unroll
        for (int i = 0; i < 8; ++i) s[i] = 0.f;
        for (int step = 0; step < 4; ++step) { const int n = dir ? 3 - step : step;
            const v4u U = *(const v4u*)(Uctx + ((size_t)combo * 4 + n) * 16384 + e); const float* dp = DEC + ((size_t)combo * 68 + n) * 128 + dk0; const f32x4 d0 = *(const f32x4*)dp, d1 = *(const f32x4*)(dp + 4);
            s[0] = d0[0] * s[0] + lo16(U.x); s[1] = d0[1] * s[1] + hi16(U.x); s[2] = d0[2] * s[2] + lo16(U.y); s[3] = d0[3] * s[3] + hi16(U.y);
            s[4] = d1[0] * s[4] + lo16(U.z); s[5] = d1[1] * s[5] + hi16(U.z); s[6] = d1[2] * s[6] + lo16(U.w); s[7] = d1[3] * s[7] + hi16(U.w); }
#pragma unroll 8
        for (int step = 0; step < 64; ++step) { const int n = dir ? 63 - step : step; bf16* p = S + ((size_t)combo * 64 + n) * 16384 + e;
            const v4u U = *(const v4u*)p; const float* dp = DEC + ((size_t)combo * 68 + 4 + n) * 128 + dk0; const f32x4 d0 = *(const f32x4*)dp, d1 = *(const f32x4*)(dp + 4);
            v4u o; o.x = pk2(s[0], s[1]); o.y = pk2(s[2], s[3]); o.z = pk2(s[4], s[5]); o.w = pk2(s[6], s[7]); if (!dry) *(v4u*)p = o;
            s[0] = d0[0] * s[0] + lo16(U.x); s[1] = d0[1] * s[1] + hi16(U.x); s[2] = d0[2] * s[2] + lo16(U.y); s[3] = d0[3] * s[3] + hi16(U.y);
            s[4] = d1[0] * s[4] + lo16(U.z); s[5] = d1[1] * s[5] + hi16(U.z); s[6] = d1[2] * s[6] + lo16(U.w); s[7] = d1[3] * s[7] + hi16(U.w); }
    }
}

DI void gla_c_unit(const Args& A, LAS unsigned char* lds, int u, int tid, int wave, int lane) {
    const bf16* Z = (const bf16*)(A.ws + WS_Z);
    const int b = u >> 8, h = (u >> 6) & 3, n = u & 63, m0 = b * SEQ + n * 64;
    gla_gates(lds, Z, m0, h, A.in[12], A.in[13], tid, wave, lane);
    LAS float* gbuf = (LAS float*)(lds + GL_GBUF);
    LAS bf16* qk = (LAS bf16*)(lds + GL_Y);
#pragma unroll
    for (int it = 0; it < 2; ++it) { const int s = tid & 63, dg = (tid >> 6) + 8 * it;
        const v4u qw = *(const v4u*)(Z + (size_t)(m0 + s) * ZW + ZGQ + h * 128 + dg * 8), kw = *(const v4u*)(Z + (size_t)(m0 + s) * ZW + ZGK + h * 128 + dg * 8);
        float r0[8], r1[8], r2[8], r3[8];
#pragma unroll
        for (int e = 0; e < 8; ++e) { const int d = dg * 8 + e; const unsigned qwd = qw[e >> 1], kwd = kw[e >> 1];
            const float qf = ((e & 1) ? hi16(qwd) : lo16(qwd)) * GLA_QSCALE, kf = (e & 1) ? hi16(kwd) : lo16(kwd);
            const float bf_ = gbuf[s * GP + d], bb_ = gbuf[(64 + s) * GP + d];
            r0[e] = qf * __expf(bf_); r1[e] = kf * __expf(-bf_); r2[e] = qf * __expf(bb_); r3[e] = kf * __expf(-bb_); }
        v4u o;
        o.x = pk2(r0[0], r0[1]); o.y = pk2(r0[2], r0[3]); o.z = pk2(r0[4], r0[5]); o.w = pk2(r0[6], r0[7]); *(LAS v4u*)(qk + (0 * 64 + s) * 136 + dg * 8) = o;
        o.x = pk2(r1[0], r1[1]); o.y = pk2(r1[2], r1[3]); o.z = pk2(r1[4], r1[5]); o.w = pk2(r1[6], r1[7]); *(LAS v4u*)(qk + (1 * 64 + s) * 136 + dg * 8) = o;
        o.x = pk2(r2[0], r2[1]); o.y = pk2(r2[2], r2[3]); o.z = pk2(r2[4], r2[5]); o.w = pk2(r2[6], r2[7]); *(LAS v4u*)(qk + (2 * 64 + s) * 136 + dg * 8) = o;
        o.x = pk2(r3[0], r3[1]); o.y = pk2(r3[2], r3[3]); o.z = pk2(r3[4], r3[5]); o.w = pk2(r3[6], r3[7]); *(LAS v4u*)(qk + (3 * 64 + s) * 136 + dg * 8) = o; }
    __syncthreads();
    LAS bf16* vT = (LAS bf16*)lds;
    LAS bf16* Am = (LAS bf16*)(lds + 18432);
    LAS float* part = (LAS float*)(lds + 27648);
#pragma unroll
    for (int it = 0; it < 2; ++it) { const int s = tid & 63, dg = (tid >> 6) + 8 * it;
        const v4u vw = *(const v4u*)(Z + (size_t)(m0 + s) * ZW + ZGV + h * 128 + dg * 8);
#pragma unroll
        for (int e = 0; e < 8; ++e) { const unsigned vwd = vw[e >> 1]; vT[(dg * 8 + e) * 72 + s] = (bf16)((e & 1) ? (vwd >> 16) : (vwd & 0xffffu)); } }
    const int fr = lane & 15, fq = lane >> 4;
#pragma unroll
    for (int bi = 0; bi < 2; ++bi) { const int blk = wave * 2 + bi, ib = blk >> 2, sb = blk & 3;
        f32x4 af_ = {0.f, 0.f, 0.f, 0.f}, ab_ = {0.f, 0.f, 0.f, 0.f};
#pragma unroll
        for (int ks = 0; ks < 4; ++ks) {
            const bf16x8 q0 = *(const LAS bf16x8*)(qk + (0 * 64 + ib * 16 + fr) * 136 + ks * 32 + fq * 8), k0 = *(const LAS bf16x8*)(qk + (1 * 64 + sb * 16 + fr) * 136 + ks * 32 + fq * 8);
            const bf16x8 q1 = *(const LAS bf16x8*)(qk + (2 * 64 + ib * 16 + fr) * 136 + ks * 32 + fq * 8), k1 = *(const LAS bf16x8*)(qk + (3 * 64 + sb * 16 + fr) * 136 + ks * 32 + fq * 8);
            af_ = MFMA16(q0, k0, af_); ab_ = MFMA16(q1, k1, ab_); }
#pragma unroll
        for (int j = 0; j < 4; ++j) { const int i = ib * 16 + 4 * fq + j, s = sb * 16 + fr; const float val = (s <= i ? af_[j] : 0.f) + (s >= i ? ab_[j] : 0.f); Am[i * 72 + s] = (bf16)f2bf(val); } }
    __syncthreads();
    const int ib = wave & 3, dvh = wave >> 2; const int combo0 = (b * 4 + h) * 2;
    const bf16* Sf = (const bf16*)A.out + ((size_t)(combo0 + 0) * 64 + n) * 16384; const bf16* Sb = (const bf16*)A.out + ((size_t)(combo0 + 1) * 64 + n) * 16384;
    bf16x8 bam[2], bqf[4], bqb[4];
#pragma unroll
    for (int ks = 0; ks < 2; ++ks) bam[ks] = *(const LAS bf16x8*)(Am + (ib * 16 + fr) * 72 + ks * 32 + fq * 8);
#pragma unroll
    for (int ks = 0; ks < 4; ++ks) { bqf[ks] = *(const LAS bf16x8*)(qk + (0 * 64 + ib * 16 + fr) * 136 + ks * 32 + fq * 8); bqb[ks] = *(const LAS bf16x8*)(qk + (2 * 64 + ib * 16 + fr) * 136 + ks * 32 + fq * 8); }
    f32x4 o[4]; float ss = 0.f;
#pragma unroll
    for (int dvi = 0; dvi < 4; ++dvi) { const int dvb = dvh * 4 + dvi; f32x4 acc = {0.f, 0.f, 0.f, 0.f};
#pragma unroll
        for (int ks = 0; ks < 2; ++ks) { const bf16x8 a = *(const LAS bf16x8*)(vT + (dvb * 16 + fr) * 72 + ks * 32 + fq * 8); acc = MFMA16(a, bam[ks], acc); }
#pragma unroll
        for (int ks = 0; ks < 4; ++ks) { const bf16x8 a = *(const bf16x8*)(Sf + (size_t)(dvb * 16 + fr) * 128 + ks * 32 + fq * 8); acc = MFMA16(a, bqf[ks], acc); }
#pragma unroll
        for (int ks = 0; ks < 4; ++ks) { const bf16x8 a = *(const bf16x8*)(Sb + (size_t)(dvb * 16 + fr) * 128 + ks * 32 + fq * 8); acc = MFMA16(a, bqb[ks], acc); }
        o[dvi] = acc; ss += (acc[0] * acc[0] + acc[1] * acc[1]) + (acc[2] * acc[2] + acc[3] * acc[3]); }
    ss += __shfl_xor(ss, 16); ss += __shfl_xor(ss, 32);
    if (fq == 0) part[dvh * 64 + ib * 16 + fr] = ss;
    __syncthreads();
    const float rstd = __builtin_amdgcn_rsqf((part[ib * 16 + fr] + part[64 + ib * 16 + fr]) * (1.f / 128.f) + EPS);
    const int row = m0 + ib * 16 + fr; const float* ng = A.in[14]; bf16* Y = (bf16*)(A.ws + WS_Y);
#pragma unroll
    for (int dvi = 0; dvi < 4; ++dvi) { const int dv0 = (dvh * 4 + dvi) * 16 + 4 * fq; const f32x4 g = *(const f32x4*)(ng + dv0);
        const v2u rw = *(const v2u*)(Z + (size_t)row * ZW + ZGR + h * 128 + dv0);
        const float r0 = lo16(rw.x), r1 = hi16(rw.x), r2 = lo16(rw.y), r3 = hi16(rw.y);
        const float y0 = o[dvi][0] * rstd * g[0] * (r0 * sigmoidf_(r0)), y1 = o[dvi][1] * rstd * g[1] * (r1 * sigmoidf_(r1)), y2 = o[dvi][2] * rstd * g[2] * (r2 * sigmoidf_(r2)), y3 = o[dvi][3] * rstd * g[3] * (r3 * sigmoidf_(r3));
        v2u w; w.x = pk2(y0, y1); w.y = pk2(y2, y3); *(v2u*)(Y + (size_t)row * 512 + h * 128 + dv0) = w; }
    __syncthreads();
}

typedef float f32x16 __attribute__((ext_vector_type(16)));
#define MFMA32(a, b, c) __builtin_amdgcn_mfma_f32_32x32x16_bf16((a), (b), (c), 0, 0, 0)
constexpr int AT_VP = 136;
constexpr int AT_VOFF = 13312, AT_STAGE = AT_VOFF + 64 * AT_VP, AT_NT = LK / 64;
constexpr float AT_THR = 8.f;
DI f32x16 splat16(float v) { return (f32x16){v, v, v, v, v, v, v, v, v, v, v, v, v, v, v, v}; }
DI void attn_qk(f32x16 (&st)[2], const LAS unsigned char* Kt, const bf16x8 (&qf)[6], float nm, int l31, int hi) {
#pragma unroll
    for (int kb = 0; kb < 2; ++kb) { st[kb] = splat16(nm);
#pragma unroll
        for (int ks = 0; ks < 6; ++ks) { const bf16x8 kf = *(const LAS bf16x8*)(Kt + (kb * 32 + l31) * 208 + ks * 32 + hi * 16); st[kb] = MFMA32(kf, qf[ks], st[kb]); } }
}
DI void attn_unit(const Args& A, LAS unsigned char* lds, int u, int tid, int wave, int lane, bool dry) {
    const int bh = u >> 4, qb = u & 15, b = bh >> 3, h = bh & 7, l31 = lane & 31, hi = lane >> 5;
    bf16* Qn = (bf16*)(A.ws + WS_QN); const bf16* Qr = (const bf16*)(A.ws + WS_QR);
    const bf16* Kn = (const bf16*)(A.ws + WS_KN) + (size_t)bh * LK * 64; const bf16* Kr = (const bf16*)(A.ws + WS_KR) + (size_t)b * LK * 32; const bf16* VT = (const bf16*)(A.ws + WS_VT) + (size_t)bh * 64 * LK;
    const size_t row = (size_t)b * SEQ + qb * 256 + wave * 32 + l31;
    bf16x8 qf[6];
#pragma unroll
    for (int ks = 0; ks < 4; ++ks) qf[ks] = *(const bf16x8*)(Qn + row * 512 + h * 64 + ks * 16 + hi * 8);
#pragma unroll
    for (int ks = 4; ks < 6; ++ks) qf[ks] = *(const bf16x8*)(Qr + row * 256 + h * 32 + (ks - 4) * 16 + hi * 8);
    f32x16 oacc[2] = {splat16(0.f), splat16(0.f)};
    float mrun = 0.f, lrun = 0.f;
    const int kkey = tid >> 3, kch = tid & 7, rkey = (tid >> 2) & 63, rch = tid & 3;
    v4u kreg, rreg = {0u, 0u, 0u, 0u}, vreg;
#define ATT_GLOAD(t) do { const int key0_ = (t) * 64; kreg = *(const v4u*)(Kn + (size_t)(key0_ + kkey) * 64 + kch * 8); if (tid < 256) rreg = *(const v4u*)(Kr + (size_t)(key0_ + rkey) * 32 + rch * 8); \
        vreg = *(const v4u*)(VT + (size_t)kkey * LK + key0_ + kch * 8); } while (0)
#define ATT_LSTORE(st_) do { LAS unsigned char* base_ = lds + (st_) * AT_STAGE; *(LAS v4u*)(base_ + kkey * 208 + kch * 16) = kreg; if (tid < 256) *(LAS v4u*)(base_ + rkey * 208 + 128 + rch * 16) = rreg; \
        LAS unsigned char* vb_ = base_ + AT_VOFF + kkey * AT_VP + kch * 16; v2u v0_, v1_; v0_.x = vreg.x; v0_.y = vreg.y; v1_.x = vreg.z; v1_.y = vreg.w; *(LAS v2u*)vb_ = v0_; *(LAS v2u*)(vb_ + 8) = v1_; } while (0)
#define AT_MAX3(a_, b_, c_) ({ float r_; asm("v_max3_f32 %0, %1, %2, %3" : "=v"(r_) : "v"(a_), "v"(b_), "v"(c_)); r_; })
#define AT_KFRAG(i_) (*(const LAS bf16x8*)(Kt_ + (((i_) & 1) * 32 + l31) * 208 + ((i_) >> 1) * 32 + hi * 16))
#define AT_VFRAG(dvb_, g_) ({ const LAS unsigned char* vp_ = Vt_ + ((dvb_) * 32 + l31) * AT_VP + (((g_) >> 1) * 32 + 16 * ((g_) & 1) + 4 * hi) * 2; \
        const v2u lo_ = *(const LAS v2u*)vp_, hi_ = *(const LAS v2u*)(vp_ + 16); v4u vv_; vv_.x = lo_.x; vv_.y = lo_.y; vv_.z = hi_.x; vv_.w = hi_.y; __builtin_bit_cast(bf16x8, vv_); })
#define AT_GROUP(g_, CUR, NXT, kc_, vc_, kn_, vn_) do { \
        if ((g_) < 3) { kn_[0] = AT_KFRAG(3 * ((g_) + 1)); kn_[1] = AT_KFRAG(3 * ((g_) + 1) + 1); kn_[2] = AT_KFRAG(3 * ((g_) + 1) + 2); vn_[0] = AT_VFRAG(0, (g_) + 1); vn_[1] = AT_VFRAG(1, (g_) + 1); } \
        NXT[(3 * (g_)) & 1] = MFMA32(kc_[0], qf[(3 * (g_)) >> 1], NXT[(3 * (g_)) & 1]); \
        NXT[(3 * (g_) + 1) & 1] = MFMA32(kc_[1], qf[(3 * (g_) + 1) >> 1], NXT[(3 * (g_) + 1) & 1]); \
        NXT[(3 * (g_) + 2) & 1] = MFMA32(kc_[2], qf[(3 * (g_) + 2) >> 1], NXT[(3 * (g_) + 2) & 1]); \
        float e_[8]; \
        _Pragma("unroll") for (int j = 0; j < 8; ++j) e_[j] = __builtin_amdgcn_exp2f(CUR[(g_) >> 1][8 * ((g_) & 1) + j]); \
        v4u w_; w_.x = pk2(e_[0], e_[1]); w_.y = pk2(e_[2], e_[3]); w_.z = pk2(e_[4], e_[5]); w_.w = pk2(e_[6], e_[7]); const bf16x8 pf_ = __builtin_bit_cast(bf16x8, w_); \
          \
        asm volatile("s_nop 0\n\tv_add_f32 %0, %0, %1\n\tv_add_f32 %0, %0, %2\n\tv_add_f32 %0, %0, %3\n\tv_add_f32 %0, %0, %4\n\tv_add_f32 %0, %0, %5\n\tv_add_f32 %0, %0, %6\n\tv_add_f32 %0, %0, %7\n\tv_add_f32 %0, %0, %8" \
                     : "+v"(ps_) : "v"(e_[0]), "v"(e_[1]), "v"(e_[2]), "v"(e_[3]), "v"(e_[4]), "v"(e_[5]), "v"(e_[6]), "v"(e_[7])); \
        oacc[0] = MFMA32(vc_[0], pf_, oacc[0]); oacc[1] = MFMA32(vc_[1], pf_, oacc[1]); \
        __builtin_amdgcn_sched_barrier(0); } while (0)
#define ATT_STEP(T, CUR, NXT) do { \
        const int t_ = (T); const int sc_ = t_ % 3, sn_ = (t_ + 1) % 3, sl_ = (t_ + 2) % 3; \
        if (t_ + 2 < AT_NT) ATT_GLOAD(t_ + 2); \
        float mx_ = AT_MAX3(CUR[0][0], CUR[0][1], CUR[0][2]); \
        _Pragma("unroll") for (int r = 3; r < 15; r += 2) mx_ = AT_MAX3(mx_, CUR[0][r], CUR[0][r + 1]); \
        mx_ = AT_MAX3(mx_, CUR[0][15], CUR[1][0]); \
        _Pragma("unroll") for (int r = 1; r < 15; r += 2) mx_ = AT_MAX3(mx_, CUR[1][r], CUR[1][r + 1]); \
        mx_ = AT_MAX3(mx_, CUR[1][15], CUR[1][15]);     \
        { const unsigned mu_ = __builtin_bit_cast(unsigned, mx_); const auto sw_ = __builtin_amdgcn_permlane32_swap(mu_, mu_, false, false); \
          mx_ = fmaxf(__builtin_bit_cast(float, sw_[0]), __builtin_bit_cast(float, sw_[1])); } \
        if (__any((t_ == 0) || (mx_ > AT_THR))) { \
            const float dl_ = (t_ == 0) ? mx_ : fmaxf(mx_, 0.f), sf_ = (t_ == 0) ? 1.f : __builtin_amdgcn_exp2f(-dl_);     \
            mrun += dl_; lrun *= sf_; CUR[0] = CUR[0] - dl_; CUR[1] = CUR[1] - dl_; oacc[0] = oacc[0] * sf_; oacc[1] = oacc[1] * sf_; } \
        const LAS unsigned char* Kt_ = lds + sn_ * AT_STAGE; const LAS unsigned char* Vt_ = lds + sc_ * AT_STAGE + AT_VOFF; \
        bf16x8 ka_[3], kb_[3], va_[2], vb_[2]; float ps_ = 0.f; \
        NXT[0] = splat16(-mrun); NXT[1] = splat16(-mrun); \
        ka_[0] = AT_KFRAG(0); ka_[1] = AT_KFRAG(1); ka_[2] = AT_KFRAG(2); va_[0] = AT_VFRAG(0, 0); va_[1] = AT_VFRAG(1, 0); \
        __builtin_amdgcn_sched_barrier(0); \
        AT_GROUP(0, CUR, NXT, ka_, va_, kb_, vb_); AT_GROUP(1, CUR, NXT, kb_, vb_, ka_, va_); AT_GROUP(2, CUR, NXT, ka_, va_, kb_, vb_); AT_GROUP(3, CUR, NXT, kb_, vb_, ka_, va_); \
        lrun += ps_; \
        if (t_ + 2 < AT_NT) ATT_LSTORE(sl_); \
        __syncthreads(); } while (0)
    ATT_GLOAD(0); ATT_LSTORE(0); ATT_GLOAD(1); ATT_LSTORE(1); __syncthreads();
    f32x16 sta[2], stb[2] = {splat16(0.f), splat16(0.f)};
    attn_qk(sta, lds, qf, 0.f, l31, hi);
    __builtin_amdgcn_sched_barrier(0); asm volatile("s_nop 15\n\ts_nop 15\n\ts_nop 15" ::: "memory"); __builtin_amdgcn_sched_barrier(0);
    for (int t = 0; t < AT_NT; t += 2) { ATT_STEP(t, sta, stb); ATT_STEP(t + 1, stb, sta); }
    if (!dry) { const float inv = 1.f / (lrun + __shfl_xor(lrun, 32));
#pragma unroll
        for (int dvb = 0; dvb < 2; ++dvb)
#pragma unroll
            for (int rq = 0; rq < 4; ++rq) { v2u w; w.x = pk2(oacc[dvb][4 * rq] * inv, oacc[dvb][4 * rq + 1] * inv); w.y = pk2(oacc[dvb][4 * rq + 2] * inv, oacc[dvb][4 * rq + 3] * inv);
                *(v2u*)(Qn + row * 512 + h * 64 + dvb * 32 + 8 * rq + 4 * hi) = w; } }
#undef ATT_STEP
#undef AT_GROUP
#undef AT_KFRAG
#undef AT_VFRAG
#undef AT_MAX3
#undef ATT_GLOAD
#undef ATT_LSTORE
}

DI float gelu1(float v) {
    const float av = fabsf(v), t = __builtin_amdgcn_rcpf(av * 0.2316418882f + 1.0f);
    float q = t * 0.5307027145f + (-0.7265760135f); q = q * t + 0.7107068705f; q = q * t + (-0.142248368f); q = q * t + 0.127414796f; q = q * t;
    const float e = __builtin_amdgcn_exp2f((v * v) * (-0.72134752044f)); const float m = v * (q * e);
    return v < 0.f ? m : v - m;
}
DI f32x2 up2(unsigned w) { return (f32x2){lo16(w), hi16(w)}; }
DI f32x2 gelu_pk(f32x2 v) {
    const f32x2 av = __builtin_elementwise_abs(v), d = av * 0.2316418882f + 1.0f;
    f32x2 t; t.x = __builtin_amdgcn_rcpf(d.x); t.y = __builtin_amdgcn_rcpf(d.y);
    f32x2 q = t * 0.5307027145f + (-0.7265760135f); q = q * t + 0.7107068705f; q = q * t + (-0.142248368f); q = q * t + 0.127414796f; q = q * t;
    const f32x2 s = (v * v) * (-0.72134752044f);
    f32x2 e; e.x = __builtin_amdgcn_exp2f(s.x); e.y = __builtin_amdgcn_exp2f(s.y);
    const f32x2 m = v * (q * e), r = v - m;
    f32x2 o; o.x = v.x < 0.f ? m.x : r.x; o.y = v.y < 0.f ? m.y : r.y; return o;
}
DI void conv_phase(const Args& A, int tid, bool dry) {
    bf16* VG = (bf16*)(A.ws + WS_Z); const bf16* cw = (const bf16*)(A.ws + WS_CONVW); const float* cb = A.in[21];
    const int gt = blockIdx.x * 512 + tid, GT = gridDim.x * 512;
    const v4u zero4 = {0u, 0u, 0u, 0u};
    for (int item = gt; item < NBATCH * 64 * 2 * 352; item += GT) {
        const int cgp = item % 352, rest = item / 352, half = rest & 1, r = (rest >> 1) & 63, b = rest >> 7, c0 = half * 32;
        f32x2 w[9][4];
#pragma unroll
        for (int tap = 0; tap < 9; ++tap) { const v4u ww = *(const v4u*)(cw + tap * FF + cgp * 8); w[tap][0] = up2(ww.x); w[tap][1] = up2(ww.y); w[tap][2] = up2(ww.z); w[tap][3] = up2(ww.w); }
        f32x2 bias[4]; { const f32x4 b0 = *(const f32x4*)(cb + cgp * 8), b1 = *(const f32x4*)(cb + cgp * 8 + 4); bias[0] = (f32x2){b0[0], b0[1]}; bias[1] = (f32x2){b0[2], b0[3]}; bias[2] = (f32x2){b1[0], b1[1]}; bias[3] = (f32x2){b1[2], b1[3]}; }
        const size_t m0 = (size_t)b * SEQ + r * 64;
        const bf16* gb = VG + FF + cgp * 8; bf16* vb = VG + cgp * 8;
        const bool ok0 = r > 0, ok2 = r < 63;
        v4u g[3][4];
#define CLOAD(dy, ok, c) (((ok) && (c) >= 0 && (c) < 64) ? *(const v4u*)(gb + (m0 + ((dy) - 1) * 64 + (c)) * FF2) : zero4)
        g[0][0] = zero4; g[1][0] = zero4; g[2][0] = zero4;
        g[0][1] = CLOAD(0, ok0, c0 - 1); g[1][1] = CLOAD(1, true, c0 - 1); g[2][1] = CLOAD(2, ok2, c0 - 1);
        g[0][2] = CLOAD(0, ok0, c0); g[1][2] = CLOAD(1, true, c0); g[2][2] = CLOAD(2, ok2, c0);
        g[0][3] = CLOAD(0, ok0, c0 + 1); g[1][3] = CLOAD(1, true, c0 + 1); g[2][3] = CLOAD(2, ok2, c0 + 1);
        v4u vnext = *(const v4u*)(vb + (m0 + c0) * FF2);
#pragma unroll 2
        for (int c = c0; c < c0 + 32; ++c) {
#pragma unroll
            for (int dy = 0; dy < 3; ++dy) { g[dy][0] = g[dy][1]; g[dy][1] = g[dy][2]; g[dy][2] = g[dy][3]; }
            g[0][3] = CLOAD(0, ok0, c + 2); g[1][3] = CLOAD(1, true, c + 2); g[2][3] = CLOAD(2, ok2, c + 2);
            const v4u vv = vnext; if (c + 1 < c0 + 32) vnext = *(const v4u*)(vb + (m0 + c + 1) * FF2);
            f32x2 acc[4] = {bias[0], bias[1], bias[2], bias[3]};
#pragma unroll
            for (int dy = 0; dy < 3; ++dy)
#pragma unroll
                for (int dx = 0; dx < 3; ++dx) { const v4u gg = g[dy][dx];
                    acc[0] += up2(gg.x) * w[dy * 3 + dx][0]; acc[1] += up2(gg.y) * w[dy * 3 + dx][1]; acc[2] += up2(gg.z) * w[dy * 3 + dx][2]; acc[3] += up2(gg.w) * w[dy * 3 + dx][3]; }
            const f32x2 o0 = gelu_pk(acc[0]) * up2(vv.x), o1 = gelu_pk(acc[1]) * up2(vv.y), o2 = gelu_pk(acc[2]) * up2(vv.z), o3 = gelu_pk(acc[3]) * up2(vv.w);
            v4u o; o.x = pk2(o0.x, o0.y); o.y = pk2(o1.x, o1.y); o.z = pk2(o2.x, o2.y); o.w = pk2(o3.x, o3.y);
            if (!dry) *(v4u*)(vb + (m0 + c) * FF2) = o;
        }
#undef CLOAD
    }
}

#define RLX_AGENT __ATOMIC_RELAXED, __HIP_MEMORY_SCOPE_AGENT
#define XB_TMO      128
#define XB_XCNT(j)  (256  + 64 * (j))
#define XB_XSUB(j)  (1280 + 64 * (j))
#define XB_XGEN(j)  (2304 + 64 * (j))
#define XB_TOP      3328
#define XB_TOPGEN   3392
#define XCD_BAR_WORDS 3456
#define XB_SPIN_CAP (1u << 18)

__device__ __forceinline__ unsigned xb_ld(unsigned* p)              { return __hip_atomic_load(p, __ATOMIC_RELAXED, __HIP_MEMORY_SCOPE_AGENT); }
__device__ __forceinline__ unsigned xb_add(unsigned* p, unsigned v) { return __hip_atomic_fetch_add(p, v, __ATOMIC_RELAXED, __HIP_MEMORY_SCOPE_AGENT); }
__device__ __forceinline__ unsigned xb_xcc_id() { return (unsigned)__builtin_amdgcn_s_getreg((3 << 11) | 20) & 0xFu; }
#define XB_SPIN(cond, bar) do { unsigned _sp = 0; while (cond) { __builtin_amdgcn_s_sleep(1); \
    if ((++_sp & 255u) == 0u) { if (xb_ld(&(bar)[XB_TMO])) break; if (_sp > XB_SPIN_CAP) { atomicAdd(&(bar)[XB_TMO], 1u); break; } } } } while (0)

struct XcdBarrier {
    unsigned* bar; unsigned x;
    volatile LAS unsigned* st;
};

__device__ __forceinline__ XcdBarrier xcd_barrier_post(unsigned* bar, volatile LAS unsigned* st) {
    XcdBarrier b; b.bar = bar; b.x = xb_xcc_id(); b.st = st;
    if (threadIdx.x == 0) (void)xb_add(&bar[XB_XCNT(b.x)], 1u);
    return b;
}
__device__ __forceinline__ void xcd_barrier_complete(unsigned* bar, unsigned x, unsigned& nloc, unsigned& nx) {
    const unsigned G = gridDim.x * gridDim.y * gridDim.z;
    unsigned sum, cnt, mine, sp = 0u;
    for (;;) {
        sum = 0u; cnt = 0u; mine = 0u;
#pragma unroll
        for (unsigned j = 0; j < 16; ++j) { const unsigned c = xb_ld(&bar[XB_XCNT(j)]); sum += c; cnt += (c > 0u) ? 1u : 0u; mine = (j == x) ? c : mine; }
        if (sum == G) break;
        __builtin_amdgcn_s_sleep(1);
        if ((++sp & 255u) == 0u) { if (xb_ld(&bar[XB_TMO])) break; if (sp > XB_SPIN_CAP) { atomicAdd(&bar[XB_TMO], 1u); break; } }
    }
    nloc = mine > 0u ? mine : 1u; nx = cnt > 0u ? cnt : 1u;
}

__device__ __forceinline__ void xcd_barrier(const XcdBarrier& b) {
    asm volatile("s_waitcnt vmcnt(0)" ::: "memory");
    __syncthreads();
    if (threadIdx.x == 0) {
        unsigned* bar = b.bar;
        __builtin_amdgcn_s_waitcnt(0);
        unsigned nloc = b.st[0], nx = b.st[1];
        if (nloc == 0u) { xcd_barrier_complete(bar, b.x, nloc, nx); b.st[0] = nloc; b.st[1] = nx; }
        const unsigned old = xb_add(&bar[XB_XSUB(b.x)], 1u);
        const unsigned gen = old / nloc;
        if (old + 1u == (gen + 1u) * nloc) {
            __builtin_amdgcn_fence(__ATOMIC_RELEASE, "agent");
            asm volatile("s_waitcnt vmcnt(0)" ::: "memory");
            const unsigned og = xb_add(&bar[XB_TOP], 1u);
            const unsigned tg = og / nx;
            if (og + 1u == (tg + 1u) * nx) xb_add(&bar[XB_TOPGEN], 1u);
            else XB_SPIN(xb_ld(&bar[XB_TOPGEN]) == tg, bar);
            __builtin_amdgcn_fence(__ATOMIC_ACQUIRE, "agent");
            xb_add(&bar[XB_XGEN(b.x)], 1u);
            asm volatile("s_waitcnt vmcnt(0)" ::: "memory");
        } else {
            XB_SPIN(xb_ld(&bar[XB_XGEN(b.x)]) == gen, bar);
            __builtin_amdgcn_fence(__ATOMIC_ACQUIRE, "agent");
            asm volatile("s_waitcnt vmcnt(0)" ::: "memory");
        }
    }
    __syncthreads();
}

#ifndef MK_DUP
#define MK_DUP 0
#endif
constexpr int LDS_BYTES = 147456;
constexpr int NPHASE = 13;
__global__ void __launch_bounds__(512, 2) mk_fwd(Args args) {
    extern __shared__ __attribute__((aligned(16))) unsigned char lds_raw[];
    LAS unsigned char* lds = (LAS unsigned char*)lds_raw;
    cg::grid_group grid = cg::this_grid();
    const int tid = threadIdx.x, lane = tid & 63, wave = __builtin_amdgcn_readfirstlane(tid >> 6);
    const int lo = args.ph_lo, hi = args.ph_hi;
    unsigned char* ws = args.ws;
    const int gw = blockIdx.x * 8 + wave, NGW = gridDim.x * 8;
    float* mod = (float*)(ws + WS_MOD);
#define IN(k) (lo <= (k) && (k) < hi)
    volatile LAS unsigned* bst = (volatile LAS unsigned*)(lds + LDS_BYTES - 64);
    if (tid < 2) bst[tid] = 0u;
    __syncthreads();
    XcdBarrier xbar = xcd_barrier_post((unsigned*)(ws + WS_BAR), bst);
    if (args.dup == 0x7fffffff) grid.sync();
#define SEAM(k) do { if (IN(k) && IN((k) + 1)) xcd_barrier(xbar); } while (0)
#define REP(bit) for (int rep_ = ((MK_DUP >> (bit)) & 1) ? 0 : 1; rep_ < 2; ++rep_)
#define DRY (rep_ == 0 && args.dup != 0)
    if (IN(0)) REP(0) { for (int it = blockIdx.x; it < 96; it += gridDim.x) p0_mod(args, (LAS float*)lds, tid, wave, lane, it); }
    SEAM(0);
    if (IN(1)) REP(1) {
        bf16* H = (bf16*)(ws + WS_H);
        for (int row = gw; row < MA; row += 2 * NGW) { const int r1 = row + NGW; const bool two = r1 < MA;
            const int b0 = row < ML ? (row >> 12) : 8, b1 = two ? (r1 < ML ? (r1 >> 12) : 8) : b0;
            const float* x0 = row < ML ? args.in[0] + (size_t)row * 1024 : args.in[2] + (size_t)(row - ML) * 1024;
            const float* x1 = two ? (r1 < ML ? args.in[0] + (size_t)r1 * 1024 : args.in[2] + (size_t)(r1 - ML) * 1024) : nullptr;
            rownorm_mod2(x0, x1, args.in[6], mod + b0 * 6144, mod + b0 * 6144 + 1024, mod + b1 * 6144, mod + b1 * 6144 + 1024, H + (size_t)row * 1024, H + (size_t)r1 * 1024, lane); }
        p0_transposes(args, lds, tid, wave, lane);
    }
    SEAM(1);
    if (IN(2)) run_inproj(lds, args);
    SEAM(2);
    if (IN(3)) {
        if ((MK_DUP >> 3) & 1) { run_gemm(lds, args, -args.dup, (const bf16*)(ws + WS_Z) + ZQ, ZW, (const bf16*)(ws + WS_WUQ), ML, 768, 384);
            run_gemm(lds, args, -args.dup, (const bf16*)(ws + WS_Z) + ZKV, ZW, (const bf16*)(ws + WS_WUKV), MA, 1024, 256); ropek_phase(args, tid); }
        run_gemm(lds, args, 2, (const bf16*)(ws + WS_Z) + ZQ, ZW, (const bf16*)(ws + WS_WUQ), ML, 768, 384);
        run_gemm(lds, args, 3, (const bf16*)(ws + WS_Z) + ZKV, ZW, (const bf16*)(ws + WS_WUKV), MA, 1024, 256);
        ropek_phase(args, tid);
        bias2_phase(args, wave, lane);
        REP(4) for (int u = (int)gridDim.x - 1 - (int)blockIdx.x; u < 2176; u += gridDim.x) gla_a_unit(args, lds, u, tid, wave, lane);
    }
    SEAM(3);
    if (IN(4)) {
        REP(5) gla_scan(args, tid, DRY);
        const int G_ = (int)gridDim.x, vcu_ = (G_ % 8 == 0) ? ((int)blockIdx.x % 8) * (G_ / 8) + (int)blockIdx.x / 8 : (int)blockIdx.x;
        REP(6) for (int u = vcu_; u < 1024; u += G_) attn_unit(args, lds, u, tid, wave, lane, DRY);
    }
    SEAM(4);
    if (IN(5)) {
        REP(7) for (int u = blockIdx.x; u < 2048; u += gridDim.x) gla_c_unit(args, lds, u, tid, wave, lane);
        { if ((MK_DUP >> 8) & 1) run_gemm(lds, args, -args.dup, (const bf16*)(ws + WS_QN), 512, (const bf16*)(ws + WS_WBRM), ML, 1024, 512); run_gemm(lds, args, 4, (const bf16*)(ws + WS_QN), 512, (const bf16*)(ws + WS_WBRM), ML, 1024, 512); }
    }
    SEAM(5);
    if (IN(6)) { if ((MK_DUP >> 9) & 1) run_gemm(lds, args, -args.dup, (const bf16*)(ws + WS_Y), 512, (const bf16*)(ws + WS_WBRG), ML, 1024, 512); run_gemm(lds, args, 5, (const bf16*)(ws + WS_Y), 512, (const bf16*)(ws + WS_WBRG), ML, 1024, 512); }
    SEAM(6);
    if (IN(7)) { if ((MK_DUP >> 10) & 1) run_gemm(lds, args, -args.dup, (const bf16*)(ws + WS_T1), 1024, (const bf16*)(ws + WS_WOUT), ML, 1024, 1024); run_gemm(lds, args, 6, (const bf16*)(ws + WS_T1), 1024, (const bf16*)(ws + WS_WOUT), ML, 1024, 1024); }
    SEAM(7);
    if (IN(9)) { if ((MK_DUP >> 12) & 1) run_gemm(lds, args, 1, (const bf16*)(ws + WS_H), 1024, (const bf16*)(ws + WS_WUP), ML, FF2, 1024); run_gemm(lds, args, 1, (const bf16*)(ws + WS_H), 1024, (const bf16*)(ws + WS_WUP), ML, FF2, 1024); }
    SEAM(9);
    if (IN(10)) REP(13) conv_phase(args, tid, DRY);
    SEAM(10);
    if (IN(11)) { if ((MK_DUP >> 14) & 1) run_gemm(lds, args, -args.dup, (const bf16*)(ws + WS_Z), FF2, (const bf16*)(ws + WS_WDOWN), ML, 1024, FF); run_gemm(lds, args, 7, (const bf16*)(ws + WS_Z), FF2, (const bf16*)(ws + WS_WDOWN), ML, 1024, FF); }
    if ((MK_DUP >> 16) & 1) { for (int i = 0; i < 10; ++i) xcd_barrier(xbar); }
    SEAM(11);
    if (IN(12)) {
        const float* fg = args.in[23];
        for (int row = gw; row < ML; row += 2 * NGW) { const int r1 = (row + NGW < ML) ? row + NGW : row;
            f32x4* xr0 = (f32x4*)(args.out + (size_t)row * 1024) + lane; f32x4* xr1 = (f32x4*)(args.out + (size_t)r1 * 1024) + lane; f32x4 v0[4], v1[4]; float s0 = 0.f, s1 = 0.f;
#pragma unroll
            for (int j = 0; j < 4; ++j) { v0[j] = xr0[64 * j]; v1[j] = xr1[64 * j]; }
#pragma unroll
            for (int j = 0; j < 4; ++j) { s0 += (v0[j].x * v0[j].x + v0[j].y * v0[j].y) + (v0[j].z * v0[j].z + v0[j].w * v0[j].w); s1 += (v1[j].x * v1[j].x + v1[j].y * v1[j].y) + (v1[j].z * v1[j].z + v1[j].w * v1[j].w); }
#pragma unroll
            for (int o = 1; o < 64; o <<= 1) { s0 += __shfl_xor(s0, o); s1 += __shfl_xor(s1, o); }
            const float q0 = __builtin_amdgcn_rsqf(s0 * (1.f / 1024.f) + EPS), q1 = __builtin_amdgcn_rsqf(s1 * (1.f / 1024.f) + EPS);
#pragma unroll
            for (int j = 0; j < 4; ++j) { const f32x4 gg = ((const f32x4*)fg)[lane + 64 * j]; xr0[64 * j] = v0[j] * q0 * gg; if (r1 != row) xr1[64 * j] = v1[j] * q1 * gg; } }
    }
#undef REP
#undef DRY
#undef IN
#undef SEAM
}

#ifndef MK_SPLIT
#define MK_SPLIT 0
#endif
extern "C" void kernel_launch(void* const* d_in, const int* in_sizes, int n_in, void* d_out, int out_size, void* d_ws, size_t ws_size, hipStream_t stream) {
    static int grid = 0;
    if (grid == 0) {
        if (n_in != 24 || out_size != ML * DM || ws_size < WS_END) { fprintf(stderr, "kernel_launch: unexpected shapes (n_in %d out %d ws %zu)\n", n_in, out_size, ws_size); grid = -1; return; }
        int dev = 0, cus = 0, per_cu = 0;
        hipGetDevice(&dev); hipDeviceGetAttribute(&cus, hipDeviceAttributeMultiprocessorCount, dev);
        if (hipFuncSetAttribute((const void*)mk_fwd, hipFuncAttributeMaxDynamicSharedMemorySize, LDS_BYTES) != hipSuccess) { fprintf(stderr, "kernel_launch: hipFuncSetAttribute failed\n"); grid = -1; return; }
        if (hipOccupancyMaxActiveBlocksPerMultiprocessor(&per_cu, (const void*)mk_fwd, 512, LDS_BYTES) != hipSuccess || per_cu < 1) { fprintf(stderr, "kernel_launch: occupancy query says %d\n", per_cu); per_cu = 1; }
        (void)hipGetLastError();
        grid = cus * 1;
        fprintf(stderr, "kernel_launch: grid %d (cus %d per_cu %d)\n", grid, cus, per_cu);
    }
    if (grid < 0) return;
    hipMemsetAsync((char*)d_ws, 0, WS_ZERO_BYTES, stream);
    Args a{};
    for (int i = 0; i < 24; ++i) a.in[i] = (const float*)d_in[i];
    a.out = (float*)d_out; a.ws = (unsigned char*)d_ws;
#if MK_SPLIT
    for (int ph = 0; ph < NPHASE; ++ph) { a.ph_lo = ph; a.ph_hi = ph + 1; void* kargs[] = {&a};
        hipError_t e = hipLaunchCooperativeKernel((const void*)mk_fwd, dim3(grid), dim3(512), kargs, LDS_BYTES, stream);
        if (e != hipSuccess) { fprintf(stderr, "cooperative launch failed (phase %d): %s\n", ph, hipGetErrorString(e)); break; } }
#else
    a.ph_lo = 0; a.ph_hi = NPHASE; a.dup = 1; void* kargs[] = {&a};
    hipError_t e = hipLaunchCooperativeKernel((const void*)mk_fwd, dim3(grid), dim3(512), kargs, LDS_BYTES, stream);
    if (e != hipSuccess) fprintf(stderr, "cooperative launch failed: %s (grid %d)\n", hipGetErrorString(e), grid);
#endif
}
```

```cpp
#include <hip/hip_runtime.h>
#include <hip/hip_cooperative_groups.h>
#include <cstdio>
#include <cstdint>
namespace cg = cooperative_groups;
namespace pg8 {
#define PG8_LAS __attribute__((address_space(3)))
typedef unsigned short bf16_t;
typedef short bf16x8 __attribute__((ext_vector_type(8)));
typedef float f32x4 __attribute__((ext_vector_type(4)));
typedef unsigned u32x4 __attribute__((ext_vector_type(4)));
constexpr int BM = 256, BK = 64, HALF = 128, HTB = HALF * BK * 2  , STAGE_BYTES = 8 * HTB, NXCD = 8, WGM = 8;

__host__ __device__ __forceinline__ int lds_byte(int r, int c) { const int st = (r >> 4) * 2 + (c >> 5), rr = r & 15, cc = c & 31, ob = rr * 64 + cc * 2; return st * 1024 + (ob ^ (((ob >> 9) & 1) << 5)); }
__host__ __device__ __forceinline__ void stage_rc(int b, int& R, int& C) { const int st = b / 1024, sb = b % 1024, swz = sb ^ (((sb >> 9) & 1) << 5); R = (st >> 1) * 16 + swz / 64; C = (st & 1) * 32 + (swz % 64) / 2; }
__host__ __device__ __forceinline__ int perm32(int rho) { const int n = rho >> 4, i = rho & 15; return 8 * (i >> 2) + 4 * n + (i & 3); }

struct Unit { int pm, pn; };
struct Gemm { const bf16_t* A; const bf16_t* Bt; int M, N, K, lda; };

struct StaticOrder {
    int nM, nN, nwg, G, c;
    __host__ __device__ void init(int M, int N, int G_, int c_) { nM = M / BM; nN = N / BM; nwg = nM * nN; G = G_; c = c_; }
    __host__ __device__ bool next(int i, Unit& u) const {
        const long L = (long)i * G + c; if (L >= nwg) return false;
        int wgid = (int)L; { const int q = nwg / NXCD, r = nwg % NXCD, xcd = wgid % NXCD, off = wgid / NXCD; wgid = (xcd < r ? xcd * (q + 1) : r * (q + 1) + (xcd - r) * q) + off; }
        const int nig = WGM * nN, gid = wgid / nig, fm = gid * WGM, gsz = (nM - fm) < WGM ? (nM - fm) : WGM;
        u.pm = fm + ((wgid % nig) % gsz); u.pn = (wgid % nig) / gsz; return true;
    }
    __device__ __forceinline__ void a_ready(const Unit&) const {}
    __device__ __forceinline__ void done(const Unit&) const {}
};


template <class Epi, class Sched, bool ALIGN_EPI = false, bool SP2 = false>
__device__ __forceinline__ void gemm_phase(PG8_LAS unsigned char* lds, const Gemm g, const Sched& S, const Epi& E) {
    const int tid = threadIdx.x, wid = __builtin_amdgcn_readfirstlane(tid >> 6), lane = tid & 63, wr = wid >> 2, wc = wid & 3, fr = lane & 15, fq = lane >> 4;
    const int K = g.K, nt = K / BK;
    unsigned voffA[2], voffB[2];
#pragma unroll
    for (int i = 0; i < 2; ++i) { int R, C; stage_rc(tid * 16 + i * 8192, R, C); const int Rb = Epi::PERM ? ((R & ~31) + perm32(R & 31)) : R;
        voffA[i] = (unsigned)(R * g.lda + C) * 2u; voffB[i] = (unsigned)(Rb * K + C) * 2u; }
    const size_t kstep = (size_t)(BK * 2);
    const size_t hstep = (size_t)HALF * K * 2;
    const size_t tstep = 2 * hstep; const size_t hstepA = (size_t)HALF * g.lda * 2, tstepA = 2 * hstepA;
    const unsigned ldsw = (unsigned)wid * 1024u;
    const int aoff = lds_byte(wr * 64 + fr, fq * 8), boff = lds_byte(wc * 32 + fr, fq * 8);
#define PG8_SA(b, h) (((b) * 2 + (h)) * HTB)
#define PG8_SB(b, h) ((4 + (b) * 2 + (h)) * HTB)
#define PG8_STAGE(bufoff, gbase, voff) do { _Pragma("unroll") for (int _i = 0; _i < 2; ++_i) \
        __builtin_amdgcn_global_load_lds((const unsigned*)((const char*)(gbase) + (voff)[_i]), (PG8_LAS unsigned*)(lds + (bufoff) + ldsw + _i * 8192), 16, 0, 0); } while (0)
#define PG8_LDA(dst, b, h) do { _Pragma("unroll") for (int m = 0; m < 4; ++m) _Pragma("unroll") for (int k = 0; k < 2; ++k) dst[m][k] = *(const PG8_LAS bf16x8*)(lds + PG8_SA(b, h) + aoff + m * 2048 + k * 1024); } while (0)
#define PG8_LDB(dst, b, h) do { _Pragma("unroll") for (int n = 0; n < 2; ++n) _Pragma("unroll") for (int k = 0; k < 2; ++k) dst[n][k] = *(const PG8_LAS bf16x8*)(lds + PG8_SB(b, h) + boff + n * 2048 + k * 1024); } while (0)
#define PG8_MMA(ai, bj, At, Bt) do { __builtin_amdgcn_s_setprio(1); _Pragma("unroll") for (int m = 0; m < 4; ++m) _Pragma("unroll") for (int n = 0; n < 2; ++n) _Pragma("unroll") for (int k = 0; k < 2; ++k) \
        acc[ai][bj][m][n] = __builtin_amdgcn_mfma_f32_16x16x32_bf16(Bt[n][k], At[m][k], acc[ai][bj][m][n], 0, 0, 0); __builtin_amdgcn_s_setprio(0); } while (0)
#define PG8_WAIT_V(n) asm volatile("s_waitcnt vmcnt(" #n ")" ::: "memory")
#define PG8_WAIT_L(n) asm volatile("s_waitcnt lgkmcnt(" #n ")" ::: "memory")
#define PG8_BAR __builtin_amdgcn_s_barrier()
#define PG8_SCHED __builtin_amdgcn_sched_barrier(0)
    Unit cur, nxt; int ui = 0;
    if (!S.next(0, cur)) return;
    f32x4 acc[2][2][4][2];
#pragma unroll
    for (int a = 0; a < 2; ++a)
#pragma unroll
        for (int b = 0; b < 2; ++b)
#pragma unroll
            for (int m = 0; m < 4; ++m)
#pragma unroll
                for (int n = 0; n < 2; ++n) acc[a][b][m][n] = (f32x4){0.f, 0.f, 0.f, 0.f};
    bf16x8 At[4][2], B0[2][2], B1[2][2];
    const char* cA = (const char*)g.A + (size_t)cur.pm * tstepA; const char* cB = (const char*)g.Bt + (size_t)cur.pn * tstep;
    S.a_ready(cur);
    if constexpr (SP2) {
        PG8_STAGE(PG8_SB(0, 0), cB, voffB); PG8_STAGE(PG8_SB(0, 1), cB + hstep, voffB); PG8_STAGE(PG8_SA(0, 0), cA, voffA); PG8_STAGE(PG8_SA(0, 1), cA + hstepA, voffA);
        if (wr == 1) PG8_BAR;
        PG8_WAIT_V(2); PG8_BAR;
        PG8_STAGE(PG8_SB(1, 0), cB + kstep, voffB); PG8_STAGE(PG8_SA(1, 0), cA + kstep, voffA); PG8_STAGE(PG8_SB(1, 1), cB + hstep + kstep, voffB);
        PG8_WAIT_V(6); PG8_BAR;
    } else {
        PG8_STAGE(PG8_SB(0, 0), cB, voffB); PG8_STAGE(PG8_SA(0, 0), cA, voffA); PG8_STAGE(PG8_SB(0, 1), cB + hstep, voffB); PG8_STAGE(PG8_SA(0, 1), cA + hstepA, voffA);
        if (wr == 1) PG8_BAR;
        PG8_WAIT_V(4); PG8_BAR;
        PG8_STAGE(PG8_SB(1, 0), cB + kstep, voffB); PG8_STAGE(PG8_SA(1, 0), cA + kstep, voffA); PG8_STAGE(PG8_SB(1, 1), cB + hstep + kstep, voffB);
        PG8_WAIT_V(6); PG8_BAR;
    }
    for (;;) {
        const bool has_next = S.next(ui + 1, nxt);
        const char* nA = has_next ? (const char*)g.A + (size_t)nxt.pm * tstepA : cA; const char* nB = has_next ? (const char*)g.Bt + (size_t)nxt.pn * tstep : cB;
        for (int t = 0; t < nt; t += 2) {
            const bool last = (t == nt - 2);
            const char* a1 = cA + (size_t)(t + 1) * kstep;
            const char* a2 = last ? nA : cA + (size_t)(t + 2) * kstep; const char* b2 = last ? nB : cB + (size_t)(t + 2) * kstep;
            const char* a3 = a2 + kstep; const char* b3 = b2 + kstep;
            if (last && has_next) S.a_ready(nxt);
            if constexpr (SP2) {
            PG8_LDB(B0, 0, 0); PG8_LDB(B1, 0, 1); PG8_SCHED; PG8_LDA(At, 0, 0); PG8_STAGE(PG8_SA(1, 1), a1 + hstepA, voffA);
            PG8_WAIT_V(8); PG8_WAIT_L(0); PG8_BAR; PG8_MMA(0, 0, At, B0); PG8_MMA(0, 1, At, B1); PG8_BAR; PG8_SCHED;
            PG8_LDA(At, 0, 1); PG8_STAGE(PG8_SB(0, 0), b2, voffB); PG8_STAGE(PG8_SB(0, 1), b2 + hstep, voffB); PG8_STAGE(PG8_SA(0, 0), a2, voffA);
            PG8_WAIT_V(8); PG8_WAIT_L(0); PG8_BAR; PG8_MMA(1, 0, At, B0); PG8_MMA(1, 1, At, B1); PG8_BAR; PG8_SCHED;
            PG8_LDB(B0, 1, 0); PG8_LDB(B1, 1, 1); PG8_SCHED; PG8_LDA(At, 1, 0); PG8_STAGE(PG8_SA(0, 1), a2 + hstepA, voffA);
            PG8_WAIT_V(8); PG8_WAIT_L(0); PG8_BAR; PG8_MMA(0, 0, At, B0); PG8_MMA(0, 1, At, B1); PG8_BAR; PG8_SCHED;
            PG8_LDA(At, 1, 1); PG8_STAGE(PG8_SB(1, 0), b3, voffB); PG8_STAGE(PG8_SB(1, 1), b3 + hstep, voffB); PG8_STAGE(PG8_SA(1, 0), a3, voffA);
            PG8_WAIT_V(8); PG8_WAIT_L(0); PG8_BAR; PG8_MMA(1, 0, At, B0); PG8_MMA(1, 1, At, B1); PG8_BAR; PG8_SCHED;
            } else {
            PG8_LDB(B0, 0, 0); PG8_SCHED; PG8_LDA(At, 0, 0); PG8_STAGE(PG8_SA(1, 1), a1 + hstepA, voffA);
            PG8_WAIT_L(8); PG8_BAR; PG8_WAIT_L(0); PG8_MMA(0, 0, At, B0); PG8_BAR; PG8_SCHED;
            PG8_LDB(B1, 0, 1); PG8_STAGE(PG8_SB(0, 0), b2, voffB);
            PG8_BAR; PG8_WAIT_L(0); PG8_MMA(0, 1, At, B1); PG8_BAR;
            PG8_LDA(At, 0, 1); PG8_STAGE(PG8_SA(0, 0), a2, voffA);
            PG8_BAR; PG8_WAIT_L(0); PG8_MMA(1, 0, At, B0); PG8_BAR; PG8_SCHED;
            PG8_STAGE(PG8_SB(0, 1), b2 + hstep, voffB);
            PG8_WAIT_V(6); PG8_BAR; PG8_MMA(1, 1, At, B1); PG8_BAR;
            PG8_LDB(B0, 1, 0); PG8_SCHED; PG8_LDA(At, 1, 0); PG8_STAGE(PG8_SA(0, 1), a2 + hstepA, voffA);
            PG8_WAIT_L(8); PG8_BAR; PG8_WAIT_L(0); PG8_MMA(0, 0, At, B0); PG8_BAR; PG8_SCHED;
            PG8_LDB(B1, 1, 1); PG8_STAGE(PG8_SB(1, 0), b3, voffB);
            PG8_BAR; PG8_WAIT_L(0); PG8_MMA(0, 1, At, B1); PG8_BAR;
            PG8_LDA(At, 1, 1); PG8_STAGE(PG8_SA(1, 0), a3, voffA);
            PG8_BAR; PG8_WAIT_L(0); PG8_MMA(1, 0, At, B0); PG8_BAR; PG8_SCHED;
            PG8_STAGE(PG8_SB(1, 1), b3 + hstep, voffB);
            PG8_WAIT_V(6); PG8_BAR; PG8_MMA(1, 1, At, B1); PG8_BAR;
            }
        }
        if constexpr (ALIGN_EPI) { if (wr == 0) PG8_BAR; }
        if constexpr (!Epi::AFTER_DRAIN) { E(acc, cur, wr, wc, fr, fq); S.done(cur); }
        if (!has_next) break;
#pragma unroll
        for (int a = 0; a < 2; ++a)
#pragma unroll
            for (int b = 0; b < 2; ++b)
#pragma unroll
                for (int m = 0; m < 4; ++m)
#pragma unroll
                    for (int n = 0; n < 2; ++n) acc[a][b][m][n] = (f32x4){0.f, 0.f, 0.f, 0.f};
        cur = nxt; cA = nA; cB = nB; ++ui;
        if constexpr (ALIGN_EPI) { if (wr == 1) PG8_BAR; }
    }
    PG8_WAIT_V(0);
    if constexpr (!ALIGN_EPI) { if (wr == 0) PG8_BAR; }
    PG8_BAR;
    if constexpr (Epi::AFTER_DRAIN) { E.fused(acc, cur, wr, wc, fr, fq, lds, wid, lane); S.done(cur); }
#undef PG8_SA
#undef PG8_SB
#undef PG8_STAGE
#undef PG8_LDA
#undef PG8_LDB
#undef PG8_MMA
#undef PG8_WAIT_V
#undef PG8_WAIT_L
#undef PG8_BAR
#undef PG8_SCHED
}
}
#define DI __device__ __forceinline__
#define LAS __attribute__((address_space(3)))
typedef unsigned short bf16;
typedef unsigned v4u __attribute__((ext_vector_type(4)));
typedef unsigned v2u __attribute__((ext_vector_type(2)));
typedef float f32x4 __attribute__((ext_vector_type(4)));
typedef float f32x2 __attribute__((ext_vector_type(2)));
typedef short bf16x8 __attribute__((ext_vector_type(8)));
typedef short s16x4 __attribute__((ext_vector_type(4)));

constexpr int DM = 1024, NBATCH = 8, SEQ = 4096, CTX = 256;
constexpr int ML = NBATCH * SEQ, MC = NBATCH * CTX, MA = ML + MC;
constexpr int ZW = 4864;
constexpr int ZQ = 0, ZKV = 384, ZKR = 640, ZGQ = 672, ZGK = 1184, ZGV = 1696, ZGR = 2208, ZGL = 2720, ZGM = 2752, ZGG = 3776;
constexpr int LK = SEQ + CTX;
constexpr int FF = 2816, FF2 = 5632;
constexpr float EPS = 1e-6f;
constexpr float QSCALE = 0.10206207261596577f * 1.4426950408889634f;
constexpr float GLA_QSCALE = 0.08838834764831845f;
constexpr size_t MiB = 1u << 20;
constexpr size_t WS_SSQ = 0, WS_SSKV = 256 * 1024, WS_BAR = 416 * 1024, WS_SS2 = 640 * 1024, WS_ZERO_BYTES = 1 * MiB, WS_MOD = 1 * MiB, WS_BIAS2 = 1 * MiB + 256 * 1024;
constexpr size_t WS_WIN = 2 * MiB, WS_WUQ = 12 * MiB, WS_WUKV = 13 * MiB, WS_WBRM = 14 * MiB, WS_WBRG = 15 * MiB, WS_WOUT = 16 * MiB, WS_WUP = 18 * MiB, WS_WDOWN = 29 * MiB, WS_CONVW = 35 * MiB;
constexpr size_t WS_H = 36 * MiB;
constexpr size_t WS_QN = 36 * MiB, WS_QR = 68 * MiB, WS_UCTX = 84 * MiB, WS_DEC = 92 * MiB, WS_Y = 68 * MiB;
constexpr size_t WS_Z = 104 * MiB;
constexpr size_t WS_KN = 427 * MiB, WS_VT = 461 * MiB, WS_KR = 495 * MiB, WS_T1 = 427 * MiB;
constexpr size_t WS_END = 512 * MiB;

struct Args {
    const float* in[24]; float* out; unsigned char* ws; int ph_lo, ph_hi, dup, pad;
};

DI float bf2f(unsigned u) { return __builtin_bit_cast(float, u << 16); }
DI unsigned pk2(float lo, float hi);
DI unsigned f2bf(float f) { return pk2(f, 0.f) & 0xffffu; }
typedef __bf16 bf16x2_t __attribute__((ext_vector_type(2)));
DI unsigned pk2(float lo, float hi) { const f32x2 v = {lo, hi}; const bf16x2_t b = __builtin_convertvector(v, bf16x2_t); return __builtin_bit_cast(unsigned, b); }
DI float lo16(unsigned w) { return __builtin_bit_cast(float, w << 16); }
DI float hi16(unsigned w) { return __builtin_bit_cast(float, w & 0xffff0000u); }
DI float wave_sum(float v) {
#pragma unroll
    for (int o = 1; o < 64; o <<= 1) v += __shfl_xor(v, o);
    return v;
}
DI float sigmoidf_(float x) { return 1.f / (1.f + __expf(-x)); }
DI float rope_invf(int i) { return __builtin_amdgcn_exp2f(-1.6609640474436813f * (float)i); }
DI int rope_perm(int r) { const int a = r >> 4, rr = r & 15, half = rr >> 3, i = rr & 7; return 16 * a + 2 * i + half; }

DI int perm_col(int mode, int n) {
    if (mode == 1) { const int h = n / 96, w = n - 96 * h; return (w >= 64) ? h * 96 + 64 + rope_perm(w - 64) : n; }
    if (mode == 2) { return (n >= ZKR && n < ZKR + 32) ? ZKR + rope_perm(n - ZKR) : n; }
    return n;
}
DI void p0_transpose_item(const float* W, int K, int N, bf16* WT, const float* kscale, int mode, LAS float* scr, int item, int lane) {
    const int nblk = N / 32, kb = item / nblk, nb = item % nblk, k0 = 64 * kb, n0 = 32 * nb;
#pragma unroll 8
    for (int i = 0; i < 32; ++i) { const int kk = 2 * i + (lane >> 5); scr[kk * 33 + (lane & 31)] = W[(size_t)(k0 + kk) * N + n0 + (lane & 31)]; }
    asm volatile("s_waitcnt lgkmcnt(0)" ::: "memory");
    const int c = lane & 7;
    float ks[8];
#pragma unroll
    for (int i = 0; i < 8; ++i) ks[i] = kscale ? kscale[k0 + 8 * c + i] : 1.f;
#pragma unroll
    for (int j = 0; j < 4; ++j) { const int n = (lane >> 3) + 8 * j; const LAS float* s = scr + (8 * c) * 33 + n;
        v4u o; o.x = pk2(s[0 * 33] * ks[0], s[1 * 33] * ks[1]); o.y = pk2(s[2 * 33] * ks[2], s[3 * 33] * ks[3]); o.z = pk2(s[4 * 33] * ks[4], s[5 * 33] * ks[5]); o.w = pk2(s[6 * 33] * ks[6], s[7 * 33] * ks[7]);
        *(v4u*)(WT + (size_t)perm_col(mode, n0 + n) * K + k0 + 8 * c) = o; }
    asm volatile("s_waitcnt lgkmcnt(0)" ::: "memory");
}

DI void p0_mod(const Args& A, LAS float* sc, int tid, int wave, int lane, int blk) {
    const float* c = A.in[1]; const float* cctx = A.in[3]; const float* w_ada = A.in[4]; const float* b_ada = A.in[5];
    float* mod = (float*)(A.ws + WS_MOD);
    for (int i = tid; i < 9 * 1024; i += 512) { const int r = i >> 10, k = i & 1023; const float v = (r < 8) ? c[r * 1024 + k] : cctx[k]; sc[i] = v / (1.f + __expf(-v)); }
    __syncthreads();
    const int col = blk * 64 + lane;
    float acc[9];
#pragma unroll
    for (int r = 0; r < 9; ++r) acc[r] = 0.f;
    for (int k = wave * 128; k < wave * 128 + 128; ++k) { const float w = w_ada[(size_t)k * 6144 + col];
#pragma unroll
        for (int r = 0; r < 9; ++r) acc[r] += sc[r * 1024 + k] * w; }
    LAS float* red = sc + 9 * 1024;
#pragma unroll
    for (int r = 0; r < 9; ++r) red[(wave * 9 + r) * 64 + lane] = acc[r];
    __syncthreads();
    for (int i = tid; i < 9 * 64; i += 512) { const int r = i >> 6, l = i & 63; float s = b_ada[blk * 64 + l];
#pragma unroll
        for (int w = 0; w < 8; ++w) s += red[(w * 9 + r) * 64 + l];
        mod[r * 6144 + blk * 64 + l] = s; }
    __syncthreads();
}

DI void p0_transposes(const Args& A, LAS unsigned char* lds, int tid, int wave, int lane) {
    unsigned char* ws = A.ws;
    LAS float* scr = (LAS float*)(lds + wave * 16384);
    const int gw = blockIdx.x * 8 + wave, NGW = gridDim.x * 8;
    constexpr int I1 = 16 * 150, I2 = 6 * 24, I3 = 4 * 32, I4 = 8 * 32, I5 = 8 * 32, I6 = 16 * 32, I7 = 16 * 176, I8 = 44 * 32;
    constexpr int NITEMS = I1 + I2 + I3 + I4 + I5 + I6 + I7 + I8;
    for (int it = gw; it < NITEMS; it += NGW) {
        int r = it;
        if (r < I1) { p0_transpose_item(A.in[7], 1024, 4800, (bf16*)(ws + WS_WIN), nullptr, 2, scr, r, lane); continue; } r -= I1;
        if (r < I2) { p0_transpose_item(A.in[9], 384, 768, (bf16*)(ws + WS_WUQ), A.in[8], 1, scr, r, lane); continue; } r -= I2;
        if (r < I3) { p0_transpose_item(A.in[11], 256, 1024, (bf16*)(ws + WS_WUKV), A.in[10], 0, scr, r, lane); continue; } r -= I3;
        if (r < I4) { p0_transpose_item(A.in[15], 512, 1024, (bf16*)(ws + WS_WBRM), nullptr, 0, scr, r, lane); continue; } r -= I4;
        if (r < I5) { p0_transpose_item(A.in[16], 512, 1024, (bf16*)(ws + WS_WBRG), nullptr, 0, scr, r, lane); continue; } r -= I5;
        if (r < I6) { p0_transpose_item(A.in[17], 1024, 1024, (bf16*)(ws + WS_WOUT), nullptr, 0, scr, r, lane); continue; } r -= I6;
        if (r < I7) { p0_transpose_item(A.in[19], 1024, 5632, (bf16*)(ws + WS_WUP), nullptr, 0, scr, r, lane); continue; } r -= I7;
        p0_transpose_item(A.in[22], 2816, 1024, (bf16*)(ws + WS_WDOWN), nullptr, 0, scr, r, lane);
    }
    const int gt = blockIdx.x * 512 + tid, GT = gridDim.x * 512;
    for (int i = gt; i < 64 * 1024 / 8; i += GT) *(v4u*)((bf16*)(ws + WS_WIN) + (size_t)4800 * 1024 + (size_t)i * 8) = (v4u){0u, 0u, 0u, 0u};
    for (int i = gt; i < 9 * FF / 2; i += GT) ((unsigned*)(ws + WS_CONVW))[i] = pk2(A.in[20][2 * i], A.in[20][2 * i + 1]);
}

DI void rownorm_fin(const f32x4 (&v)[4], float ssum, const float* g, const float* sh, const float* sc, bf16* orow, int lane) {
    const float rstd = __builtin_amdgcn_rsqf(ssum * (1.f / 1024.f) + EPS);
    v2u* o8 = (v2u*)orow + lane;
#pragma unroll
    for (int j = 0; j < 4; ++j) {
        const f32x4 gg = ((const f32x4*)g)[lane + 64 * j], ss = ((const f32x4*)sc)[lane + 64 * j], hh = ((const f32x4*)sh)[lane + 64 * j];
        const f32x4 y = v[j] * rstd * gg * (ss + 1.f) + hh;
        v2u w; w.x = pk2(y.x, y.y); w.y = pk2(y.z, y.w); o8[64 * j] = w; }
}
DI void rownorm_mod2(const float* x0, const float* x1, const float* g, const float* sh0, const float* sc0, const float* sh1, const float* sc1, bf16* o0, bf16* o1, int lane) {
    const f32x4* xr0 = (const f32x4*)x0 + lane; const f32x4* xr1 = (const f32x4*)(x1 ? x1 : x0) + lane;
    f32x4 v0[4], v1[4]; float s0 = 0.f, s1 = 0.f;
#pragma unroll
    for (int j = 0; j < 4; ++j) { v0[j] = xr0[64 * j]; v1[j] = xr1[64 * j]; }
#pragma unroll
    for (int j = 0; j < 4; ++j) { s0 += (v0[j].x * v0[j].x + v0[j].y * v0[j].y) + (v0[j].z * v0[j].z + v0[j].w * v0[j].w); s1 += (v1[j].x * v1[j].x + v1[j].y * v1[j].y) + (v1[j].z * v1[j].z + v1[j].w * v1[j].w); }
#pragma unroll
    for (int o = 1; o < 64; o <<= 1) { s0 += __shfl_xor(s0, o); s1 += __shfl_xor(s1, o); }
    rownorm_fin(v0, s0, g, sh0, sc0, o0, lane);
    if (x1) rownorm_fin(v1, s1, g, sh1, sc1, o1, lane);
}
typedef const f32x4 (&AccRef)[2][2][4][2];
DI v4u pack8(f32x4 v0, f32x4 v1) { v4u w; w.x = pk2(v0[0], v0[1]); w.y = pk2(v0[2], v0[3]); w.z = pk2(v1[0], v1[1]); w.w = pk2(v1[2], v1[3]); return w; }

DI void epi_bf16(AccRef acc, const pg8::Unit& u, int wr, int wc, int fr, int fq, bf16* O, int ldc) {
    const int row0 = u.pm * 256 + wr * 64 + fr, col0 = u.pn * 256 + wc * 32 + 8 * fq;
#pragma unroll
    for (int ai = 0; ai < 2; ++ai)
#pragma unroll
        for (int m = 0; m < 4; ++m) { bf16* rowp = O + (size_t)(row0 + ai * 128 + m * 16) * ldc + col0;
#pragma unroll
            for (int bj = 0; bj < 2; ++bj) *(v4u*)(rowp + bj * 128) = pack8(acc[ai][bj][m][0], acc[ai][bj][m][1]); }
}
DI void epi_sumsq(AccRef acc, const pg8::Unit& u, int wr, int wc, int fr, int fq, float* ssq, float* sskv) {
    if (u.pn > 2) return;
#pragma unroll
    for (int bj = 0; bj < 2; ++bj) { const int colb = u.pn * 256 + bj * 128; float* dst = colb < 384 ? ssq : (colb < 640 ? sskv : nullptr);
        if (dst) {
#pragma unroll
            for (int ai = 0; ai < 2; ++ai)
#pragma unroll
                for (int m = 0; m < 4; ++m) { const f32x4 a = acc[ai][bj][m][0], b = acc[ai][bj][m][1];
                    float s = (a[0] * a[0] + a[1] * a[1]) + (a[2] * a[2] + a[3] * a[3]) + (b[0] * b[0] + b[1] * b[1]) + (b[2] * b[2] + b[3] * b[3]);
                    s += __shfl_xor(s, 16); s += __shfl_xor(s, 32);
                    if (fq == 0) atomicAdd(dst + (u.pm * 256 + ai * 128 + wr * 64 + m * 16 + fr), s); } } }
}
DI void epi_q(AccRef acc, const pg8::Unit& u, int wr, int wc, int fr, int fq, const float* ssq, bf16* Qn, bf16* Qr) {
#pragma unroll
    for (int ai = 0; ai < 2; ++ai)
#pragma unroll
        for (int m = 0; m < 4; ++m) { const int row = u.pm * 256 + ai * 128 + wr * 64 + m * 16 + fr;
            const float rs = __builtin_amdgcn_rsqf(ssq[row] * (1.f / 384.f) + EPS) * QSCALE; const int t = row & 4095; const float prow = (float)(t >> 6), pcol = (float)(t & 63);
#pragma unroll
            for (int bj = 0; bj < 2; ++bj)
#pragma unroll
                for (int n = 0; n < 2; ++n) { const int col4 = u.pn * 256 + bj * 128 + wc * 32 + 8 * fq + 4 * n, h = col4 / 96, w = col4 - 96 * h; const f32x4 v = acc[ai][bj][m][n] * rs;
                    if (w < 64) { v2u o; o.x = pk2(v[0], v[1]); o.y = pk2(v[2], v[3]); *(v2u*)(Qn + (size_t)row * 512 + h * 64 + w) = o; }
                    else { const int r0 = w - 64, a = r0 >> 4, i0 = (r0 & 15) >> 1; const float pos = a ? pcol : prow;
                        const float a0 = pos * rope_invf(i0), a1 = pos * rope_invf(i0 + 1); const float c0 = __cosf(a0), s0 = __sinf(a0), c1 = __cosf(a1), s1 = __sinf(a1);
                        v2u o; o.x = pk2(v[0] * c0 - v[1] * s0, v[1] * c0 + v[0] * s0); o.y = pk2(v[2] * c1 - v[3] * s1, v[3] * c1 + v[2] * s1);
                        *(v2u*)(Qr + (size_t)row * 256 + h * 32 + r0) = o; } } }
}
DI void epi_kv(AccRef acc, const pg8::Unit& u, int wr, int wc, int fr, int fq, const float* sskv, bf16* Kn, bf16* VT) {
#pragma unroll
    for (int ai = 0; ai < 2; ++ai)
#pragma unroll
        for (int m = 0; m < 4; ++m) { const int row = u.pm * 256 + ai * 128 + wr * 64 + m * 16 + fr;
            const float rs = __builtin_amdgcn_rsqf(sskv[row] * (1.f / 256.f) + EPS);
            int b, key; if (row < ML) { b = row >> 12; key = row & 4095; } else { const int r = row - ML; b = r >> 8; key = SEQ + (r & 255); }
#pragma unroll
            for (int bj = 0; bj < 2; ++bj) { const int h = u.pn * 2 + bj; const f32x4 v0 = acc[ai][bj][m][0] * rs, v1 = acc[ai][bj][m][1] * rs;
                if (wc < 2) { *(v4u*)(Kn + ((size_t)(b * 8 + h) * LK + key) * 64 + wc * 32 + 8 * fq) = pack8(v0, v1); }
                else { bf16* p = VT + ((size_t)(b * 8 + h) * 64 + (wc - 2) * 32 + 8 * fq) * LK + key;
                    p[0] = (bf16)f2bf(v0[0]); p[LK] = (bf16)f2bf(v0[1]); p[2 * LK] = (bf16)f2bf(v0[2]); p[3 * LK] = (bf16)f2bf(v0[3]);
                    p[4 * LK] = (bf16)f2bf(v1[0]); p[5 * LK] = (bf16)f2bf(v1[1]); p[6 * LK] = (bf16)f2bf(v1[2]); p[7 * LK] = (bf16)f2bf(v1[3]); } } }
}
DI void epi_t1(AccRef acc, const pg8::Unit& u, int wr, int wc, int fr, int fq, const bf16* Z, bf16* T1, bool second) {
    const int goff = second ? ZGG : ZGM;
#pragma unroll
    for (int ai = 0; ai < 2; ++ai)
#pragma unroll
        for (int m = 0; m < 4; ++m) { const int row = u.pm * 256 + ai * 128 + wr * 64 + m * 16 + fr;
#pragma unroll
            for (int bj = 0; bj < 2; ++bj) { const int col8 = u.pn * 256 + bj * 128 + wc * 32 + 8 * fq;
                const v4u g = *(const v4u*)(Z + (size_t)row * ZW + goff + col8);
                f32x4 v0 = acc[ai][bj][m][0], v1 = acc[ai][bj][m][1];
                v0[0] *= sigmoidf_(lo16(g.x)); v0[1] *= sigmoidf_(hi16(g.x)); v0[2] *= sigmoidf_(lo16(g.y)); v0[3] *= sigmoidf_(hi16(g.y));
                v1[0] *= sigmoidf_(lo16(g.z)); v1[1] *= sigmoidf_(hi16(g.z)); v1[2] *= sigmoidf_(lo16(g.w)); v1[3] *= sigmoidf_(hi16(g.w));
                bf16* dst = T1 + (size_t)row * 1024 + col8;
                if (second) { const v4u t = *(const v4u*)dst;
                    v0[0] += lo16(t.x); v0[1] += hi16(t.x); v0[2] += lo16(t.y); v0[3] += hi16(t.y); v1[0] += lo16(t.z); v1[1] += hi16(t.z); v1[2] += lo16(t.w); v1[3] += hi16(t.w); }
                *(v4u*)dst = pack8(v0, v1); } }
}
DI void epi_res(AccRef acc, const pg8::Unit& u, int wr, int wc, int fr, int fq, const float* base, const float* gate, float* dst) {
#pragma unroll
    for (int ai = 0; ai < 2; ++ai)
#pragma unroll
        for (int m = 0; m < 4; ++m) { const int row = u.pm * 256 + ai * 128 + wr * 64 + m * 16 + fr; const float* gp = gate + (size_t)(row >> 12) * 6144;
#pragma unroll
            for (int bj = 0; bj < 2; ++bj)
#pragma unroll
                for (int n = 0; n < 2; ++n) { const int col4 = u.pn * 256 + bj * 128 + wc * 32 + 8 * fq + 4 * n;
                    const f32x4 xb = *(const f32x4*)(base + (size_t)row * 1024 + col4), gg = *(const f32x4*)(gp + col4);
                    *(f32x4*)(dst + (size_t)row * 1024 + col4) = xb + gg * acc[ai][bj][m][n]; } }
}
DI void epi_x1(AccRef acc, const pg8::Unit& u, int wr, int wc, int fr, int fq, const float* x, const float* mod, float* dst, const float* g2, bf16* H2, float* ss2) {
    const float* mb = mod + (size_t)((u.pm * 256) >> 12) * 6144;
    f32x4 gt[2][2], gm[2][2];
#pragma unroll
    for (int bj = 0; bj < 2; ++bj)
#pragma unroll
        for (int n = 0; n < 2; ++n) { const int col4 = u.pn * 256 + bj * 128 + wc * 32 + 8 * fq + 4 * n;
            gt[bj][n] = *(const f32x4*)(mb + 2048 + col4); gm[bj][n] = *(const f32x4*)(g2 + col4) * (*(const f32x4*)(mb + 4096 + col4) + 1.f); }
#pragma unroll
    for (int ai = 0; ai < 2; ++ai)
#pragma unroll
        for (int m = 0; m < 4; ++m) { const int row = u.pm * 256 + ai * 128 + wr * 64 + m * 16 + fr; float ssum = 0.f;
#pragma unroll
            for (int bj = 0; bj < 2; ++bj) { const int col8 = u.pn * 256 + bj * 128 + wc * 32 + 8 * fq;
                const f32x4 x0 = *(const f32x4*)(x + (size_t)row * 1024 + col8) + gt[bj][0] * acc[ai][bj][m][0], x1 = *(const f32x4*)(x + (size_t)row * 1024 + col8 + 4) + gt[bj][1] * acc[ai][bj][m][1];
                *(f32x4*)(dst + (size_t)row * 1024 + col8) = x0; *(f32x4*)(dst + (size_t)row * 1024 + col8 + 4) = x1;
                ssum += (x0[0] * x0[0] + x0[1] * x0[1]) + (x0[2] * x0[2] + x0[3] * x0[3]) + (x1[0] * x1[0] + x1[1] * x1[1]) + (x1[2] * x1[2] + x1[3] * x1[3]);
                *(v4u*)(H2 + (size_t)row * 1024 + col8) = pack8(x0 * gm[bj][0], x1 * gm[bj][1]); }
            ssum += __shfl_xor(ssum, 16); ssum += __shfl_xor(ssum, 32);
            if (fq == 0) atomicAdd(ss2 + row, ssum); }
}
DI void epi_up(AccRef acc, const pg8::Unit& u, int wr, int wc, int fr, int fq, bf16* VG, const float* ss2, const float* bias2) {
    const float* bb = bias2 + (size_t)((u.pm * 256) >> 12) * FF2;
    f32x4 bv[2][2];
#pragma unroll
    for (int bj = 0; bj < 2; ++bj)
#pragma unroll
        for (int n = 0; n < 2; ++n) bv[bj][n] = *(const f32x4*)(bb + u.pn * 256 + bj * 128 + wc * 32 + 8 * fq + 4 * n);
#pragma unroll
    for (int ai = 0; ai < 2; ++ai)
#pragma unroll
        for (int m = 0; m < 4; ++m) { const int row = u.pm * 256 + ai * 128 + wr * 64 + m * 16 + fr; const float rs = __builtin_amdgcn_rsqf(ss2[row] * (1.f / 1024.f) + EPS);
            bf16* rowp = VG + (size_t)row * FF2 + u.pn * 256 + wc * 32 + 8 * fq;
#pragma unroll
            for (int bj = 0; bj < 2; ++bj) *(v4u*)(rowp + bj * 128) = pack8(acc[ai][bj][m][0] * rs + bv[bj][0], acc[ai][bj][m][1] * rs + bv[bj][1]); }
}
DI void bias2_phase(const Args& A, int wave, int lane) {
    const bf16* Wup = (const bf16*)(A.ws + WS_WUP); const float* mod = (const float*)(A.ws + WS_MOD); float* b2 = (float*)(A.ws + WS_BIAS2);
    for (int n = blockIdx.x * 8 + wave; n < FF2; n += gridDim.x * 8) {
        const v4u w0 = *(const v4u*)(Wup + (size_t)n * 1024 + lane * 16), w1 = *(const v4u*)(Wup + (size_t)n * 1024 + lane * 16 + 8);
        const f32x4 wa = {lo16(w0.x), hi16(w0.x), lo16(w0.y), hi16(w0.y)}, wb = {lo16(w0.z), hi16(w0.z), lo16(w0.w), hi16(w0.w)}, wc_ = {lo16(w1.x), hi16(w1.x), lo16(w1.y), hi16(w1.y)}, wd = {lo16(w1.z), hi16(w1.z), lo16(w1.w), hi16(w1.w)};
#pragma unroll
        for (int b = 0; b < NBATCH; ++b) { const f32x4* sh = (const f32x4*)(mod + (size_t)b * 6144 + 3072 + lane * 16);
            const f32x4 p = sh[0] * wa + sh[1] * wb + sh[2] * wc_ + sh[3] * wd; const float t = wave_sum((p[0] + p[1]) + (p[2] + p[3]));
            if (lane == 0) b2[(size_t)b * FF2 + n] = t; }
    }
}
DI void epi_x2(AccRef acc, const pg8::Unit& u, int wr, int wc, int fr, int fq, const float* base, const float* gate, bf16* dst) {
#pragma unroll
    for (int ai = 0; ai < 2; ++ai)
#pragma unroll
        for (int m = 0; m < 4; ++m) { const int row = u.pm * 256 + ai * 128 + wr * 64 + m * 16 + fr; const float* gp = gate + (size_t)(row >> 12) * 6144;
#pragma unroll
            for (int bj = 0; bj < 2; ++bj) { const int col8 = u.pn * 256 + bj * 128 + wc * 32 + 8 * fq;
                const f32x4 x0 = *(const f32x4*)(base + (size_t)row * 1024 + col8) + *(const f32x4*)(gp + col8) * acc[ai][bj][m][0];
                const f32x4 x1 = *(const f32x4*)(base + (size_t)row * 1024 + col8 + 4) + *(const f32x4*)(gp + col8 + 4) * acc[ai][bj][m][1];
                *(v4u*)(dst + (size_t)row * 1024 + col8) = pack8(x0, x1); } }
}
namespace pg8 {
struct EpiAll {
    static constexpr bool PERM = true, AFTER_DRAIN = false;
    int mode; unsigned char* ws; const float* x; float* out; const float* g2;
    __device__ __forceinline__ void operator()(const f32x4 (&acc)[2][2][4][2], const Unit& u, int wr, int wc, int fr, int fq) const {
        float* mod = (float*)(ws + WS_MOD);
        if (mode < 0) return;
        switch (mode) {
        case 0: epi_bf16(acc, u, wr, wc, fr, fq, (bf16*)(ws + WS_Z), ZW); epi_sumsq(acc, u, wr, wc, fr, fq, (float*)(ws + WS_SSQ), (float*)(ws + WS_SSKV)); break;
        case 1: epi_up(acc, u, wr, wc, fr, fq, (bf16*)(ws + WS_Z), (const float*)(ws + WS_SS2), (const float*)(ws + WS_BIAS2)); break;
        case 2: epi_q(acc, u, wr, wc, fr, fq, (const float*)(ws + WS_SSQ), (bf16*)(ws + WS_QN), (bf16*)(ws + WS_QR)); break;
        case 3: epi_kv(acc, u, wr, wc, fr, fq, (const float*)(ws + WS_SSKV), (bf16*)(ws + WS_KN), (bf16*)(ws + WS_VT)); break;
        case 4: epi_t1(acc, u, wr, wc, fr, fq, (const bf16*)(ws + WS_Z), (bf16*)(ws + WS_T1), false); break;
        case 5: epi_t1(acc, u, wr, wc, fr, fq, (const bf16*)(ws + WS_Z), (bf16*)(ws + WS_T1), true); break;
        case 6: epi_x1(acc, u, wr, wc, fr, fq, x, mod, out, g2, (bf16*)(ws + WS_H), (float*)(ws + WS_SS2)); break;
        default: epi_x2(acc, u, wr, wc, fr, fq, out, mod + 5120, (bf16*)(ws + WS_H)); break;
        }
    }
};
}

struct InProjOrder {
    pg8::StaticOrder base; int G, c;
    __device__ void init(int G_, int c_) { base.init(ML, ZW, G_, c_); G = G_; c = c_; }
    __device__ bool next(int i, pg8::Unit& u) const {
        const long L = (long)i * G + c;
        if (L < 128 * 19) return base.next(i, u);
        const int k = (int)L - 128 * 19; if (k >= 64) return false;
        const int j = k >> 3; u.pm = 128 + (k & 7); u.pn = j < 2 ? j + 1 : (j < 7 ? j + 2 : 10); return true;
    }
    __device__ __forceinline__ void a_ready(const pg8::Unit&) const {}
    __device__ __forceinline__ void done(const pg8::Unit&) const {}
};
DI void run_inproj(LAS unsigned char* lds, const Args& A) {
    pg8::Gemm g{(const bf16*)(A.ws + WS_H), (const bf16*)(A.ws + WS_WIN), MA, ZW, 1024, 1024}; InProjOrder S; S.init((int)gridDim.x, (int)blockIdx.x);
    pg8::EpiAll E{0, A.ws, A.in[0], A.out, A.in[18]};
    pg8::gemm_phase<pg8::EpiAll, InProjOrder, true, true>(lds, g, S, E);
}
DI void run_gemm(LAS unsigned char* lds, const Args& A, int mode, const bf16* Am, int lda, const bf16* Bt, int M, int N, int K) {
    pg8::Gemm g{Am, Bt, M, N, K, lda}; pg8::StaticOrder S; S.init(M, N, (int)gridDim.x, (int)blockIdx.x);
    pg8::EpiAll E{mode, A.ws, A.in[0], A.out, A.in[18]};
    pg8::gemm_phase<pg8::EpiAll, pg8::StaticOrder, true, true>(lds, g, S, E);
}

DI void ropek_phase(const Args& A, int tid) {
    const bf16* Z = (const bf16*)(A.ws + WS_Z); bf16* Kr = (bf16*)(A.ws + WS_KR);
    const int gt = blockIdx.x * 512 + tid, GT = gridDim.x * 512;
    for (int idx = gt; idx < MA * 8; idx += GT) { const int row = idx >> 3, g = idx & 7;
        const v2u w = *(const v2u*)(Z + (size_t)row * ZW + ZKR + 4 * g);
        float v0 = lo16(w.x), v1 = hi16(w.x), v2 = lo16(w.y), v3 = hi16(w.y);
        int b, key;
        if (row < ML) { b = row >> 12; key = row & 4095; const int r0 = 4 * g, a = r0 >> 4, i0 = (r0 & 15) >> 1; const float pos = a ? (float)(key & 63) : (float)(key >> 6);
            const float a0 = pos * rope_invf(i0), a1 = pos * rope_invf(i0 + 1); const float c0 = __cosf(a0), s0 = __sinf(a0), c1 = __cosf(a1), s1 = __sinf(a1);
            const float y0 = v0 * c0 - v1 * s0, y1 = v1 * c0 + v0 * s0, y2 = v2 * c1 - v3 * s1, y3 = v3 * c1 + v2 * s1; v0 = y0; v1 = y1; v2 = y2; v3 = y3; }
        else { const int r = row - ML; b = r >> 8; key = SEQ + (r & 255); }
        v2u o; o.x = pk2(v0, v1); o.y = pk2(v2, v3); *(v2u*)(Kr + ((size_t)b * LK + key) * 32 + 4 * g) = o; }
}

#define MFMA16(a, b, c) __builtin_amdgcn_mfma_f32_16x16x32_bf16((a), (b), (c), 0, 0, 0)
DI float logsig(float x) { return fminf(x, 0.f) - __logf(1.f + __expf(-fabsf(x))); }
constexpr int GP = 129;
constexpr int GL_GBUF = 0, GL_BLAST = 2 * 64 * GP * 4, GL_Y = 75776;
DI void gla_gates(LAS unsigned char* lds, const bf16* Z, int m0, int h, const float* wdec, const float* bdec, int tid, int wave, int lane) {
    LAS float* gbuf = (LAS float*)(lds + GL_GBUF); LAS float* blast = (LAS float*)(lds + GL_BLAST);
    {
        const int fr = lane & 15, fq = lane >> 4, dir = wave >> 2;
        bf16x8 af[4];
#pragma unroll
        for (int tb = 0; tb < 4; ++tb) af[tb] = *(const bf16x8*)(Z + (size_t)(m0 + tb * 16 + fr) * ZW + ZGL + fq * 8);
#pragma unroll
        for (int i = 0; i < 2; ++i) { const int d = ((wave & 3) * 2 + i) * 16 + fr;
            v4u bw = {0u, 0u, 0u, 0u};
            if ((fq >> 1) == dir) { const float* wp = wdec + (size_t)(dir * 16 + (fq & 1) * 8) * 512 + h * 128 + d;
                bw.x = pk2(wp[0], wp[512]); bw.y = pk2(wp[2 * 512], wp[3 * 512]); bw.z = pk2(wp[4 * 512], wp[5 * 512]); bw.w = pk2(wp[6 * 512], wp[7 * 512]); }
            const bf16x8 bfrag = __builtin_bit_cast(bf16x8, bw); const float bias = bdec[dir * 512 + h * 128 + d];
#pragma unroll
            for (int tb = 0; tb < 4; ++tb) { f32x4 acc = {0.f, 0.f, 0.f, 0.f}; acc = MFMA16(af[tb], bfrag, acc);
#pragma unroll
                for (int j = 0; j < 4; ++j) gbuf[(dir * 64 + tb * 16 + 4 * fq + j) * GP + d] = logsig(acc[j] + bias) * (1.f / 16.f); } }
    }
    __syncthreads();
    {
        const int d = tid & 127, dir = (tid >> 7) & 1, hf = tid >> 8; LAS float* g = gbuf + dir * (64 * GP) + d; LAS float* tot = blast + 256;
        float v[32];
#pragma unroll
        for (int i = 0; i < 32; ++i) v[i] = g[(hf * 32 + i) * GP];
        if (dir == 0) {
#pragma unroll
            for (int i = 1; i < 32; ++i) v[i] += v[i - 1];
            tot[(hf * 2 + dir) * 128 + d] = v[31];
        } else {
#pragma unroll
            for (int i = 30; i >= 0; --i) v[i] += v[i + 1];
            tot[(hf * 2 + dir) * 128 + d] = v[0];
        }
        __syncthreads();
        const float other = tot[((1 - hf) * 2 + dir) * 128 + d];
        const float add = (dir == 0) ? (hf == 1 ? other : 0.f) : (hf == 0 ? other : 0.f);
#pragma unroll
        for (int i = 0; i < 32; ++i) g[(hf * 32 + i) * GP] = v[i] + add;
        if (hf == 0) blast[dir * 128 + d] = ((dir == 0) ? other : v[0]) + ((dir == 0) ? v[31] : other);
    }
    __syncthreads();
}

DI void gla_a_unit(const Args& A, LAS unsigned char* lds, int u, int tid, int wave, int lane) {
    const bf16* Z = (const bf16*)(A.ws + WS_Z);
    int b, h, n, m0; const bool isctx = u >= 2048;
    if (!isctx) { b = u >> 8; h = (u >> 6) & 3; n = u & 63; m0 = b * SEQ + n * 64; } else { const int uc = u - 2048; b = uc >> 4; h = (uc >> 2) & 3; n = uc & 3; m0 = ML + b * CTX + n * 64; }
    gla_gates(lds, Z, m0, h, A.in[12], A.in[13], tid, wave, lane);
    LAS float* gbuf = (LAS float*)(lds + GL_GBUF); LAS float* blast = (LAS float*)(lds + GL_BLAST);
    LAS bf16* kdT = (LAS bf16*)(lds + GL_Y);
    LAS bf16* vT = (LAS bf16*)(lds + GL_Y + 36864);
    const int combo0 = (b * 4 + h) * 2;
    if (tid < 256) { const int dir = tid >> 7, d = tid & 127; ((float*)(A.ws + WS_DEC))[((size_t)(combo0 + dir) * 68 + (isctx ? n : 4 + n)) * 128 + d] = __expf(blast[dir * 128 + d]); }
#pragma unroll
    for (int it = 0; it < 2; ++it) { const int s = tid & 63, dg = (tid >> 6) + 8 * it;
        const v4u kw = *(const v4u*)(Z + (size_t)(m0 + s) * ZW + ZGK + h * 128 + dg * 8), vw = *(const v4u*)(Z + (size_t)(m0 + s) * ZW + ZGV + h * 128 + dg * 8);
#pragma unroll
        for (int e = 0; e < 8; ++e) { const int d = dg * 8 + e; const unsigned kwd = kw[e >> 1], vwd = vw[e >> 1]; const float kf = (e & 1) ? hi16(kwd) : lo16(kwd);
            const float ef = __expf(blast[d] - gbuf[s * GP + d]), eb = __expf(blast[128 + d] - gbuf[(64 + s) * GP + d]);
            kdT[d * 72 + s] = (bf16)f2bf(kf * ef); kdT[(128 + d) * 72 + s] = (bf16)f2bf(kf * eb); vT[d * 72 + s] = (bf16)((e & 1) ? (vwd >> 16) : (vwd & 0xffffu)); } }
    __syncthreads();
    const int fr = lane & 15, fq = lane >> 4, dir = wave >> 2, dkb0 = (wave & 3) * 2;
    bf16x8 af[2][2];
#pragma unroll
    for (int i = 0; i < 2; ++i)
#pragma unroll
        for (int ks = 0; ks < 2; ++ks) af[i][ks] = *(const LAS bf16x8*)(kdT + (dir * 128 + (dkb0 + i) * 16 + fr) * 72 + ks * 32 + fq * 8);
    bf16* dst = isctx ? (bf16*)(A.ws + WS_UCTX) + ((size_t)(combo0 + dir) * 4 + n) * 16384 : (bf16*)A.out + ((size_t)(combo0 + dir) * 64 + n) * 16384;
#pragma unroll 2
    for (int dvb = 0; dvb < 8; ++dvb) { const bf16x8 b0 = *(const LAS bf16x8*)(vT + (dvb * 16 + fr) * 72 + fq * 8), b1 = *(const LAS bf16x8*)(vT + (dvb * 16 + fr) * 72 + 32 + fq * 8);
#pragma unroll
        for (int i = 0; i < 2; ++i) { f32x4 acc = {0.f, 0.f, 0.f, 0.f}; acc = MFMA16(af[i][0], b0, acc); acc = MFMA16(af[i][1], b1, acc);
            v2u o; o.x = pk2(acc[0], acc[1]); o.y = pk2(acc[2], acc[3]); *(v2u*)(dst + (size_t)(dvb * 16 + fr) * 128 + (dkb0 + i) * 16 + 4 * fq) = o; } }
    __syncthreads();
}

DI void gla_scan(const Args& A, int tid, bool dry) {
    bf16* S = (bf16*)A.out; const bf16* Uctx = (const bf16*)(A.ws + WS_UCTX); const float* DEC = (const float*)(A.ws + WS_DEC);
    for (int item = blockIdx.x * 512 + tid; item < 64 * 2048; item += gridDim.x * 512) {
        const int combo = item >> 11, e = (item & 2047) * 8, dk0 = e & 127, dir = combo & 1;
        float s[8];
#pragma unroll
        for (int i = 0; i < 8; ++i) s[i] = 0.f;
        for (int step = 0; step < 4; ++step) { const int n = dir ? 3 - step : step;
            const v4u U = *(const v4u*)(Uctx + ((size_t)combo * 4 + n) * 16384 + e); const float* dp = DEC + ((size_t)combo * 68 + n) * 128 + dk0; const f32x4 d0 = *(const f32x4*)dp, d1 = *(const f32x4*)(dp + 4);
            s[0] = d0[0] * s[0] + lo16(U.x); s[1] = d0[1] * s[1] + hi16(U.x); s[2] = d0[2] * s[2] + lo16(U.y); s[3] = d0[3] * s[3] + hi16(U.y);
            s[4] = d1[0] * s[4] + lo16(U.z); s[5] = d1[1] * s[5] + hi16(U.z); s[6] = d1[2] * s[6] + lo16(U.w); s[7] = d1[3] * s[7] + hi16(U.w); }
#pragma unroll 8
        for (int step = 0; step < 64; ++step) { const int n = dir ? 63 - step : step; bf16* p = S + ((size_t)combo * 64 + n) * 16384 + e;
            const v4u U = *(const v4u*)p; const float* dp = DEC + ((size_t)combo * 68 + 4 + n) * 128 + dk0; const f32x4 d0 = *(const f32x4*)dp, d1 = *(const f32x4*)(dp + 4);
            v4u o; o.x = pk2(s[0], s[1]); o.y = pk2(s[2], s[3]); o.z = pk2(s[4], s[5]); o.w = pk2(s[6], s[7]); if (!dry) *(v4u*)p = o;
            s[0] = d0[0] * s[0] + lo16(U.x); s[1] = d0[1] * s[1] + hi16(U.x); s[2] = d0[2] * s[2] + lo16(U.y); s[3] = d0[3] * s[3] + hi16(U.y);
            s[4] = d1[0] * s[4] + lo16(U.z); s[5] = d1[1] * s[5] + hi16(U.z); s[6] = d1[2] * s[6] + lo16(U.w); s[7] = d1[3] * s[7] + hi16(U.w); }
    }
}

DI void gla_c_unit(const Args& A, LAS unsigned char* lds, int u, int tid, int wave, int lane) {
    const bf16* Z = (const bf16*)(A.ws + WS_Z);
    const int b = u >> 8, h = (u >> 6) & 3, n = u & 63, m0 = b * SEQ + n * 64;
    gla_gates(lds, Z, m0, h, A.in[12], A.in[13], tid, wave, lane);
    LAS float* gbuf = (LAS float*)(lds + GL_GBUF);
    LAS bf16* qk = (LAS bf16*)(lds + GL_Y);
#pragma unroll
    for (int it = 0; it < 2; ++it) { const int s = tid & 63, dg = (tid >> 6) + 8 * it;
        const v4u qw = *(const v4u*)(Z + (size_t)(m0 + s) * ZW + ZGQ + h * 128 + dg * 8), kw = *(const v4u*)(Z + (size_t)(m0 + s) * ZW + ZGK + h * 128 + dg * 8);
        float r0[8], r1[8], r2[8], r3[8];
#pragma unroll
        for (int e = 0; e < 8; ++e) { const int d = dg * 8 + e; const unsigned qwd = qw[e >> 1], kwd = kw[e >> 1];
            const float qf = ((e & 1) ? hi16(qwd) : lo16(qwd)) * GLA_QSCALE, kf = (e & 1) ? hi16(kwd) : lo16(kwd);
            const float bf_ = gbuf[s * GP + d], bb_ = gbuf[(64 + s) * GP + d];
            r0[e] = qf * __expf(bf_); r1[e] = kf * __expf(-bf_); r2[e] = qf * __expf(bb_); r3[e] = kf * __expf(-bb_); }
        v4u o;
        o.x = pk2(r0[0], r0[1]); o.y = pk2(r0[2], r0[3]); o.z = pk2(r0[4], r0[5]); o.w = pk2(r0[6], r0[7]); *(LAS v4u*)(qk + (0 * 64 + s) * 136 + dg * 8) = o;
        o.x = pk2(r1[0], r1[1]); o.y = pk2(r1[2], r1[3]); o.z = pk2(r1[4], r1[5]); o.w = pk2(r1[6], r1[7]); *(LAS v4u*)(qk + (1 * 64 + s) * 136 + dg * 8) = o;
        o.x = pk2(r2[0], r2[1]); o.y = pk2(r2[2], r2[3]); o.z = pk2(r2[4], r2[5]); o.w = pk2(r2[6], r2[7]); *(LAS v4u*)(qk + (2 * 64 + s) * 136 + dg * 8) = o;
        o.x = pk2(r3[0], r3[1]); o.y = pk2(r3[2], r3[3]); o.z = pk2(r3[4], r3[5]); o.w = pk2(r3[6], r3[7]); *(LAS v4u*)(qk + (3 * 64 + s) * 136 + dg * 8) = o; }
    __syncthreads();
    LAS bf16* vT = (LAS bf16*)lds;
    LAS bf16* Am = (LAS bf16*)(lds + 18432);
    LAS float* part = (LAS float*)(lds + 27648);
#pragma unroll
    for (int it = 0; it < 2; ++it) { const int s = tid & 63, dg = (tid >> 6) + 8 * it;
        const v4u vw = *(const v4u*)(Z + (size_t)(m0 + s) * ZW + ZGV + h * 128 + dg * 8);
#pragma unroll
        for (int e = 0; e < 8; ++e) { const unsigned vwd = vw[e >> 1]; vT[(dg * 8 + e) * 72 + s] = (bf16)((e & 1) ? (vwd >> 16) : (vwd & 0xffffu)); } }
    const int fr = lane & 15, fq = lane >> 4;
#pragma unroll
    for (int bi = 0; bi < 2; ++bi) { const int blk = wave * 2 + bi, ib = blk >> 2, sb = blk & 3;
        f32x4 af_ = {0.f, 0.f, 0.f, 0.f}, ab_ = {0.f, 0.f, 0.f, 0.f};
#pragma unroll
        for (int ks = 0; ks < 4; ++ks) {
            const bf16x8 q0 = *(const LAS bf16x8*)(qk + (0 * 64 + ib * 16 + fr) * 136 + ks * 32 + fq * 8), k0 = *(const LAS bf16x8*)(qk + (1 * 64 + sb * 16 + fr) * 136 + ks * 32 + fq * 8);
            const bf16x8 q1 = *(const LAS bf16x8*)(qk + (2 * 64 + ib * 16 + fr) * 136 + ks * 32 + fq * 8), k1 = *(const LAS bf16x8*)(qk + (3 * 64 + sb * 16 + fr) * 136 + ks * 32 + fq * 8);
            af_ = MFMA16(q0, k0, af_); ab_ = MFMA16(q1, k1, ab_); }
#pragma unroll
        for (int j = 0; j < 4; ++j) { const int i = ib * 16 + 4 * fq + j, s = sb * 16 + fr; const float val = (s <= i ? af_[j] : 0.f) + (s >= i ? ab_[j] : 0.f); Am[i * 72 + s] = (bf16)f2bf(val); } }
    __syncthreads();
    const int ib = wave & 3, dvh = wave >> 2; const int combo0 = (b * 4 + h) * 2;
    const bf16* Sf = (const bf16*)A.out + ((size_t)(combo0 + 0) * 64 + n) * 16384; const bf16* Sb = (const bf16*)A.out + ((size_t)(combo0 + 1) * 64 + n) * 16384;
    bf16x8 bam[2], bqf[4], bqb[4];
#pragma unroll
    for (int ks = 0; ks < 2; ++ks) bam[ks] = *(const LAS bf16x8*)(Am + (ib * 16 + fr) * 72 + ks * 32 + fq * 8);
#pragma unroll
    for (int ks = 0; ks < 4; ++ks) { bqf[ks] = *(const LAS bf16x8*)(qk + (0 * 64 + ib * 16 + fr) * 136 + ks * 32 + fq * 8); bqb[ks] = *(const LAS bf16x8*)(qk + (2 * 64 + ib * 16 + fr) * 136 + ks * 32 + fq * 8); }
    f32x4 o[4]; float ss = 0.f;
#pragma unroll
    for (int dvi = 0; dvi < 4; ++dvi) { const int dvb = dvh * 4 + dvi; f32x4 acc = {0.f, 0.f, 0.f, 0.f};
#pragma unroll
        for (int ks = 0; ks < 2; ++ks) { const bf16x8 a = *(const LAS bf16x8*)(vT + (dvb * 16 + fr) * 72 + ks * 32 + fq * 8); acc = MFMA16(a, bam[ks], acc); }
#pragma unroll
        for (int ks = 0; ks < 4; ++ks) { const bf16x8 a = *(const bf16x8*)(Sf + (size_t)(dvb * 16 + fr) * 128 + ks * 32 + fq * 8); acc = MFMA16(a, bqf[ks], acc); }
#pragma unroll
        for (int ks = 0; ks < 4; ++ks) { const bf16x8 a = *(const bf16x8*)(Sb + (size_t)(dvb * 16 + fr) * 128 + ks * 32 + fq * 8); acc = MFMA16(a, bqb[ks], acc); }
        o[dvi] = acc; ss += (acc[0] * acc[0] + acc[1] * acc[1]) + (acc[2] * acc[2] + acc[3] * acc[3]); }
    ss += __shfl_xor(ss, 16); ss += __shfl_xor(ss, 32);
    if (fq == 0) part[dvh * 64 + ib * 16 + fr] = ss;
    __syncthreads();
    const float rstd = __builtin_amdgcn_rsqf((part[ib * 16 + fr] + part[64 + ib * 16 + fr]) * (1.f / 128.f) + EPS);
    const int row = m0 + ib * 16 + fr; const float* ng = A.in[14]; bf16* Y = (bf16*)(A.ws + WS_Y);
#pragma unroll
    for (int dvi = 0; dvi < 4; ++dvi) { const int dv0 = (dvh * 4 + dvi) * 16 + 4 * fq; const f32x4 g = *(const f32x4*)(ng + dv0);
        const v2u rw = *(const v2u*)(Z + (size_t)row * ZW + ZGR + h * 128 + dv0);
        const float r0 = lo16(rw.x), r1 = hi16(rw.x), r2 = lo16(rw.y), r3 = hi16(rw.y);
        const float y0 = o[dvi][0] * rstd * g[0] * (r0 * sigmoidf_(r0)), y1 = o[dvi][1] * rstd * g[1] * (r1 * sigmoidf_(r1)), y2 = o[dvi][2] * rstd * g[2] * (r2 * sigmoidf_(r2)), y3 = o[dvi][3] * rstd * g[3] * (r3 * sigmoidf_(r3));
        v2u w; w.x = pk2(y0, y1); w.y = pk2(y2, y3); *(v2u*)(Y + (size_t)row * 512 + h * 128 + dv0) = w; }
    __syncthreads();
}

typedef float f32x16 __attribute__((ext_vector_type(16)));
#define MFMA32(a, b, c) __builtin_amdgcn_mfma_f32_32x32x16_bf16((a), (b), (c), 0, 0, 0)
constexpr int AT_VP = 136;
constexpr int AT_VOFF = 13312, AT_STAGE = AT_VOFF + 64 * AT_VP, AT_NT = LK / 64;
#ifndef AT_FORCE
#define AT_FORCE 0
#endif
constexpr float AT_THR = 8.f;
DI f32x16 splat16(float v) { return (f32x16){v, v, v, v, v, v, v, v, v, v, v, v, v, v, v, v}; }
DI void attn_qk(f32x16 (&st)[2], const LAS unsigned char* Kt, const bf16x8 (&qf)[6], float nm, int l31, int hi) {
#pragma unroll
    for (int kb = 0; kb < 2; ++kb) { st[kb] = splat16(nm);
#pragma unroll
        for (int ks = 0; ks < 6; ++ks) { const bf16x8 kf = *(const LAS bf16x8*)(Kt + (kb * 32 + l31) * 208 + ks * 32 + hi * 16); st[kb] = MFMA32(kf, qf[ks], st[kb]); } }
}
DI void attn_unit(const Args& A, LAS unsigned char* lds, int u, int tid, int wave, int lane, bool dry) {
    const int bh = u >> 4, qb = u & 15, b = bh >> 3, h = bh & 7, l31 = lane & 31, hi = lane >> 5;
    bf16* Qn = (bf16*)(A.ws + WS_QN); const bf16* Qr = (const bf16*)(A.ws + WS_QR);
    const bf16* Kn = (const bf16*)(A.ws + WS_KN) + (size_t)bh * LK * 64; const bf16* Kr = (const bf16*)(A.ws + WS_KR) + (size_t)b * LK * 32; const bf16* VT = (const bf16*)(A.ws + WS_VT) + (size_t)bh * 64 * LK;
    const size_t row = (size_t)b * SEQ + qb * 256 + wave * 32 + l31;
    bf16x8 qf[6];
#pragma unroll
    for (int ks = 0; ks < 4; ++ks) qf[ks] = *(const bf16x8*)(Qn + row * 512 + h * 64 + ks * 16 + hi * 8);
#pragma unroll
    for (int ks = 4; ks < 6; ++ks) qf[ks] = *(const bf16x8*)(Qr + row * 256 + h * 32 + (ks - 4) * 16 + hi * 8);
    f32x16 oacc[2] = {splat16(0.f), splat16(0.f)};
    float mrun = 0.f, lrun = 0.f;
    const int kkey = tid >> 3, kch = tid & 7, rkey = (tid >> 2) & 63, rch = tid & 3;
    v4u kreg, rreg = {0u, 0u, 0u, 0u}, vreg;
#define ATT_GLOAD(t) do { const int key0_ = (t) * 64; kreg = *(const v4u*)(Kn + (size_t)(key0_ + kkey) * 64 + kch * 8); if (tid < 256) rreg = *(const v4u*)(Kr + (size_t)(key0_ + rkey) * 32 + rch * 8); \
        vreg = *(const v4u*)(VT + (size_t)kkey * LK + key0_ + kch * 8); } while (0)
#define ATT_LSTORE(st_) do { LAS unsigned char* base_ = lds + (st_) * AT_STAGE; *(LAS v4u*)(base_ + kkey * 208 + kch * 16) = kreg; if (tid < 256) *(LAS v4u*)(base_ + rkey * 208 + 128 + rch * 16) = rreg; \
        LAS unsigned char* vb_ = base_ + AT_VOFF + kkey * AT_VP + kch * 16; v2u v0_, v1_; v0_.x = vreg.x; v0_.y = vreg.y; v1_.x = vreg.z; v1_.y = vreg.w; *(LAS v2u*)vb_ = v0_; *(LAS v2u*)(vb_ + 8) = v1_; } while (0)
#define AT_MAX3(a_, b_, c_) ({ float r_; asm("v_max3_f32 %0, %1, %2, %3" : "=v"(r_) : "v"(a_), "v"(b_), "v"(c_)); r_; })
#define AT_KFRAG(i_) (*(const LAS bf16x8*)(Kt_ + (((i_) & 1) * 32 + l31) * 208 + ((i_) >> 1) * 32 + hi * 16))
#define AT_VFRAG(dvb_, g_) ({ const LAS unsigned char* vp_ = Vt_ + ((dvb_) * 32 + l31) * AT_VP + (((g_) >> 1) * 32 + 16 * ((g_) & 1) + 4 * hi) * 2; \
        const v2u lo_ = *(const LAS v2u*)vp_, hi_ = *(const LAS v2u*)(vp_ + 16); v4u vv_; vv_.x = lo_.x; vv_.y = lo_.y; vv_.z = hi_.x; vv_.w = hi_.y; __builtin_bit_cast(bf16x8, vv_); })
#define AT_GROUP(g_, CUR, NXT, kc_, vc_, kn_, vn_) do { \
        if ((g_) < 3) { kn_[0] = AT_KFRAG(3 * ((g_) + 1)); kn_[1] = AT_KFRAG(3 * ((g_) + 1) + 1); kn_[2] = AT_KFRAG(3 * ((g_) + 1) + 2); vn_[0] = AT_VFRAG(0, (g_) + 1); vn_[1] = AT_VFRAG(1, (g_) + 1); } \
        NXT[(3 * (g_)) & 1] = MFMA32(kc_[0], qf[(3 * (g_)) >> 1], NXT[(3 * (g_)) & 1]); \
        NXT[(3 * (g_) + 1) & 1] = MFMA32(kc_[1], qf[(3 * (g_) + 1) >> 1], NXT[(3 * (g_) + 1) & 1]); \
        NXT[(3 * (g_) + 2) & 1] = MFMA32(kc_[2], qf[(3 * (g_) + 2) >> 1], NXT[(3 * (g_) + 2) & 1]); \
        float e_[8]; \
        _Pragma("unroll") for (int j = 0; j < 8; ++j) e_[j] = __builtin_amdgcn_exp2f(CUR[(g_) >> 1][8 * ((g_) & 1) + j]); \
        v4u w_; w_.x = pk2(e_[0], e_[1]); w_.y = pk2(e_[2], e_[3]); w_.z = pk2(e_[4], e_[5]); w_.w = pk2(e_[6], e_[7]); const bf16x8 pf_ = __builtin_bit_cast(bf16x8, w_); \
          \
        asm volatile("s_nop 0\n\tv_add_f32 %0, %0, %1\n\tv_add_f32 %0, %0, %2\n\tv_add_f32 %0, %0, %3\n\tv_add_f32 %0, %0, %4\n\tv_add_f32 %0, %0, %5\n\tv_add_f32 %0, %0, %6\n\tv_add_f32 %0, %0, %7\n\tv_add_f32 %0, %0, %8" \
                     : "+v"(ps_) : "v"(e_[0]), "v"(e_[1]), "v"(e_[2]), "v"(e_[3]), "v"(e_[4]), "v"(e_[5]), "v"(e_[6]), "v"(e_[7])); \
        oacc[0] = MFMA32(vc_[0], pf_, oacc[0]); oacc[1] = MFMA32(vc_[1], pf_, oacc[1]); \
        __builtin_amdgcn_sched_barrier(0); } while (0)
#define ATT_STEP(T, CUR, NXT) do { \
        const int t_ = (T); const int sc_ = t_ % 3, sn_ = (t_ + 1) % 3, sl_ = (t_ + 2) % 3; \
        if (t_ + 2 < AT_NT) ATT_GLOAD(t_ + 2); \
        float mx_ = AT_MAX3(CUR[0][0], CUR[0][1], CUR[0][2]); \
        _Pragma("unroll") for (int r = 3; r < 15; r += 2) mx_ = AT_MAX3(mx_, CUR[0][r], CUR[0][r + 1]); \
        mx_ = AT_MAX3(mx_, CUR[0][15], CUR[1][0]); \
        _Pragma("unroll") for (int r = 1; r < 15; r += 2) mx_ = AT_MAX3(mx_, CUR[1][r], CUR[1][r + 1]); \
        mx_ = AT_MAX3(mx_, CUR[1][15], CUR[1][15]);     \
        { const unsigned mu_ = __builtin_bit_cast(unsigned, mx_); const auto sw_ = __builtin_amdgcn_permlane32_swap(mu_, mu_, false, false); \
          mx_ = fmaxf(__builtin_bit_cast(float, sw_[0]), __builtin_bit_cast(float, sw_[1])); } \
        if (__any((t_ == 0) || AT_FORCE || (mx_ > AT_THR))) { \
            const float dl_ = (t_ == 0 || AT_FORCE) ? mx_ : fmaxf(mx_, 0.f), sf_ = (t_ == 0) ? 1.f : __builtin_amdgcn_exp2f(-dl_);     \
            mrun += dl_; lrun *= sf_; CUR[0] = CUR[0] - dl_; CUR[1] = CUR[1] - dl_; oacc[0] = oacc[0] * sf_; oacc[1] = oacc[1] * sf_; } \
        const LAS unsigned char* Kt_ = lds + sn_ * AT_STAGE; const LAS unsigned char* Vt_ = lds + sc_ * AT_STAGE + AT_VOFF; \
        bf16x8 ka_[3], kb_[3], va_[2], vb_[2]; float ps_ = 0.f; \
        NXT[0] = splat16(-mrun); NXT[1] = splat16(-mrun); \
        ka_[0] = AT_KFRAG(0); ka_[1] = AT_KFRAG(1); ka_[2] = AT_KFRAG(2); va_[0] = AT_VFRAG(0, 0); va_[1] = AT_VFRAG(1, 0); \
        __builtin_amdgcn_sched_barrier(0); \
        AT_GROUP(0, CUR, NXT, ka_, va_, kb_, vb_); AT_GROUP(1, CUR, NXT, kb_, vb_, ka_, va_); AT_GROUP(2, CUR, NXT, ka_, va_, kb_, vb_); AT_GROUP(3, CUR, NXT, kb_, vb_, ka_, va_); \
        lrun += ps_; \
        if (t_ + 2 < AT_NT) ATT_LSTORE(sl_); \
        __syncthreads(); } while (0)
    ATT_GLOAD(0); ATT_LSTORE(0); ATT_GLOAD(1); ATT_LSTORE(1); __syncthreads();
    f32x16 sta[2], stb[2] = {splat16(0.f), splat16(0.f)};
    attn_qk(sta, lds, qf, 0.f, l31, hi);
    __builtin_amdgcn_sched_barrier(0); asm volatile("s_nop 15\n\ts_nop 15\n\ts_nop 15" ::: "memory"); __builtin_amdgcn_sched_barrier(0);
    for (int t = 0; t < AT_NT; t += 2) { ATT_STEP(t, sta, stb); ATT_STEP(t + 1, stb, sta); }
    if (!dry) { const float inv = 1.f / (lrun + __shfl_xor(lrun, 32));
#pragma unroll
        for (int dvb = 0; dvb < 2; ++dvb)
#pragma unroll
            for (int rq = 0; rq < 4; ++rq) { v2u w; w.x = pk2(oacc[dvb][4 * rq] * inv, oacc[dvb][4 * rq + 1] * inv); w.y = pk2(oacc[dvb][4 * rq + 2] * inv, oacc[dvb][4 * rq + 3] * inv);
                *(v2u*)(Qn + row * 512 + h * 64 + dvb * 32 + 8 * rq + 4 * hi) = w; } }
#undef ATT_STEP
#undef AT_GROUP
#undef AT_KFRAG
#undef AT_VFRAG
#undef AT_MAX3
#undef ATT_GLOAD
#undef ATT_LSTORE
}

DI float gelu1(float v) {
    const float av = fabsf(v), t = __builtin_amdgcn_rcpf(av * 0.2316418882f + 1.0f);
    float q = t * 0.5307027145f + (-0.7265760135f); q = q * t + 0.7107068705f; q = q * t + (-0.142248368f); q = q * t + 0.127414796f; q = q * t;
    const float e = __builtin_amdgcn_exp2f((v * v) * (-0.72134752044f)); const float m = v * (q * e);
    return v < 0.f ? m : v - m;
}
DI f32x2 up2(unsigned w) { return (f32x2){lo16(w), hi16(w)}; }
DI f32x2 gelu_pk(f32x2 v) {
    const f32x2 av = __builtin_elementwise_abs(v), d = av * 0.2316418882f + 1.0f;
    f32x2 t; t.x = __builtin_amdgcn_rcpf(d.x); t.y = __builtin_amdgcn_rcpf(d.y);
    f32x2 q = t * 0.5307027145f + (-0.7265760135f); q = q * t + 0.7107068705f; q = q * t + (-0.142248368f); q = q * t + 0.127414796f; q = q * t;
    const f32x2 s = (v * v) * (-0.72134752044f);
    f32x2 e; e.x = __builtin_amdgcn_exp2f(s.x); e.y = __builtin_amdgcn_exp2f(s.y);
    const f32x2 m = v * (q * e), r = v - m;
    f32x2 o; o.x = v.x < 0.f ? m.x : r.x; o.y = v.y < 0.f ? m.y : r.y; return o;
}
DI void conv_phase(const Args& A, int tid, bool dry) {
    bf16* VG = (bf16*)(A.ws + WS_Z); const bf16* cw = (const bf16*)(A.ws + WS_CONVW); const float* cb = A.in[21];
    const int gt = blockIdx.x * 512 + tid, GT = gridDim.x * 512;
    const v4u zero4 = {0u, 0u, 0u, 0u};
    for (int item = gt; item < NBATCH * 64 * 2 * 352; item += GT) {
        const int cgp = item % 352, rest = item / 352, half = rest & 1, r = (rest >> 1) & 63, b = rest >> 7, c0 = half * 32;
        f32x2 w[9][4];
#pragma unroll
        for (int tap = 0; tap < 9; ++tap) { const v4u ww = *(const v4u*)(cw + tap * FF + cgp * 8); w[tap][0] = up2(ww.x); w[tap][1] = up2(ww.y); w[tap][2] = up2(ww.z); w[tap][3] = up2(ww.w); }
        f32x2 bias[4]; { const f32x4 b0 = *(const f32x4*)(cb + cgp * 8), b1 = *(const f32x4*)(cb + cgp * 8 + 4); bias[0] = (f32x2){b0[0], b0[1]}; bias[1] = (f32x2){b0[2], b0[3]}; bias[2] = (f32x2){b1[0], b1[1]}; bias[3] = (f32x2){b1[2], b1[3]}; }
        const size_t m0 = (size_t)b * SEQ + r * 64;
        const bf16* gb = VG + FF + cgp * 8; bf16* vb = VG + cgp * 8;
        const bool ok0 = r > 0, ok2 = r < 63;
        v4u g[3][4];
#define CLOAD(dy, ok, c) (((ok) && (c) >= 0 && (c) < 64) ? *(const v4u*)(gb + (m0 + ((dy) - 1) * 64 + (c)) * FF2) : zero4)
        g[0][0] = zero4; g[1][0] = zero4; g[2][0] = zero4;
        g[0][1] = CLOAD(0, ok0, c0 - 1); g[1][1] = CLOAD(1, true, c0 - 1); g[2][1] = CLOAD(2, ok2, c0 - 1);
        g[0][2] = CLOAD(0, ok0, c0); g[1][2] = CLOAD(1, true, c0); g[2][2] = CLOAD(2, ok2, c0);
        g[0][3] = CLOAD(0, ok0, c0 + 1); g[1][3] = CLOAD(1, true, c0 + 1); g[2][3] = CLOAD(2, ok2, c0 + 1);
        v4u vnext = *(const v4u*)(vb + (m0 + c0) * FF2);
#pragma unroll 2
        for (int c = c0; c < c0 + 32; ++c) {
#pragma unroll
            for (int dy = 0; dy < 3; ++dy) { g[dy][0] = g[dy][1]; g[dy][1] = g[dy][2]; g[dy][2] = g[dy][3]; }
            g[0][3] = CLOAD(0, ok0, c + 2); g[1][3] = CLOAD(1, true, c + 2); g[2][3] = CLOAD(2, ok2, c + 2);
            const v4u vv = vnext; if (c + 1 < c0 + 32) vnext = *(const v4u*)(vb + (m0 + c + 1) * FF2);
            f32x2 acc[4] = {bias[0], bias[1], bias[2], bias[3]};
#pragma unroll
            for (int dy = 0; dy < 3; ++dy)
#pragma unroll
                for (int dx = 0; dx < 3; ++dx) { const v4u gg = g[dy][dx];
                    acc[0] += up2(gg.x) * w[dy * 3 + dx][0]; acc[1] += up2(gg.y) * w[dy * 3 + dx][1]; acc[2] += up2(gg.z) * w[dy * 3 + dx][2]; acc[3] += up2(gg.w) * w[dy * 3 + dx][3]; }
            const f32x2 o0 = gelu_pk(acc[0]) * up2(vv.x), o1 = gelu_pk(acc[1]) * up2(vv.y), o2 = gelu_pk(acc[2]) * up2(vv.z), o3 = gelu_pk(acc[3]) * up2(vv.w);
            v4u o; o.x = pk2(o0.x, o0.y); o.y = pk2(o1.x, o1.y); o.z = pk2(o2.x, o2.y); o.w = pk2(o3.x, o3.y);
            if (!dry) *(v4u*)(vb + (m0 + c) * FF2) = o;
        }
#undef CLOAD
    }
}

#define RLX_AGENT __ATOMIC_RELAXED, __HIP_MEMORY_SCOPE_AGENT
#define XB_TMO      128
#define XB_XCNT(j)  (256  + 64 * (j))
#define XB_XSUB(j)  (1280 + 64 * (j))
#define XB_XGEN(j)  (2304 + 64 * (j))
#define XB_TOP      3328
#define XB_TOPGEN   3392
#define XCD_BAR_WORDS 3456
#define XB_SPIN_CAP (1u << 18)

__device__ __forceinline__ unsigned xb_ld(unsigned* p)              { return __hip_atomic_load(p, __ATOMIC_RELAXED, __HIP_MEMORY_SCOPE_AGENT); }
__device__ __forceinline__ unsigned xb_add(unsigned* p, unsigned v) { return __hip_atomic_fetch_add(p, v, __ATOMIC_RELAXED, __HIP_MEMORY_SCOPE_AGENT); }
__device__ __forceinline__ unsigned xb_xcc_id() { return (unsigned)__builtin_amdgcn_s_getreg((3 << 11) | 20) & 0xFu; }
#define XB_SPIN(cond, bar) do { unsigned _sp = 0; while (cond) { __builtin_amdgcn_s_sleep(1); \
    if ((++_sp & 255u) == 0u) { if (xb_ld(&(bar)[XB_TMO])) break; if (_sp > XB_SPIN_CAP) { atomicAdd(&(bar)[XB_TMO], 1u); break; } } } } while (0)

struct XcdBarrier {
    unsigned* bar; unsigned x;
    volatile LAS unsigned* st;
};

__device__ __forceinline__ XcdBarrier xcd_barrier_post(unsigned* bar, volatile LAS unsigned* st) {
    XcdBarrier b; b.bar = bar; b.x = xb_xcc_id(); b.st = st;
    if (threadIdx.x == 0) (void)xb_add(&bar[XB_XCNT(b.x)], 1u);
    return b;
}
__device__ __forceinline__ void xcd_barrier_complete(unsigned* bar, unsigned x, unsigned& nloc, unsigned& nx) {
    const unsigned G = gridDim.x * gridDim.y * gridDim.z;
    unsigned sum, cnt, mine, sp = 0u;
    for (;;) {
        sum = 0u; cnt = 0u; mine = 0u;
#pragma unroll
        for (unsigned j = 0; j < 16; ++j) { const unsigned c = xb_ld(&bar[XB_XCNT(j)]); sum += c; cnt += (c > 0u) ? 1u : 0u; mine = (j == x) ? c : mine; }
        if (sum == G) break;
        __builtin_amdgcn_s_sleep(1);
        if ((++sp & 255u) == 0u) { if (xb_ld(&bar[XB_TMO])) break; if (sp > XB_SPIN_CAP) { atomicAdd(&bar[XB_TMO], 1u); break; } }
    }
    nloc = mine > 0u ? mine : 1u; nx = cnt > 0u ? cnt : 1u;
}

__device__ __forceinline__ void xcd_barrier(const XcdBarrier& b) {
    asm volatile("s_waitcnt vmcnt(0)" ::: "memory");
    __syncthreads();
    if (threadIdx.x == 0) {
        unsigned* bar = b.bar;
        __builtin_amdgcn_s_waitcnt(0);
        unsigned nloc = b.st[0], nx = b.st[1];
        if (nloc == 0u) { xcd_barrier_complete(bar, b.x, nloc, nx); b.st[0] = nloc; b.st[1] = nx; }
        const unsigned old = xb_add(&bar[XB_XSUB(b.x)], 1u);
        const unsigned gen = old / nloc;
        if (old + 1u == (gen + 1u) * nloc) {
            __builtin_amdgcn_fence(__ATOMIC_RELEASE, "agent");
            asm volatile("s_waitcnt vmcnt(0)" ::: "memory");
            const unsigned og = xb_add(&bar[XB_TOP], 1u);
            const unsigned tg = og / nx;
            if (og + 1u == (tg + 1u) * nx) xb_add(&bar[XB_TOPGEN], 1u);
            else XB_SPIN(xb_ld(&bar[XB_TOPGEN]) == tg, bar);
            __builtin_amdgcn_fence(__ATOMIC_ACQUIRE, "agent");
            xb_add(&bar[XB_XGEN(b.x)], 1u);
            asm volatile("s_waitcnt vmcnt(0)" ::: "memory");
        } else {
            XB_SPIN(xb_ld(&bar[XB_XGEN(b.x)]) == gen, bar);
            __builtin_amdgcn_fence(__ATOMIC_ACQUIRE, "agent");
            asm volatile("s_waitcnt vmcnt(0)" ::: "memory");
        }
    }
    __syncthreads();
}

#ifndef MK_DUP
#define MK_DUP 0
#endif
constexpr int LDS_BYTES = 147456;
constexpr int NPHASE = 13;
__global__ void __launch_bounds__(512, 2) mk_fwd(Args args) {
    extern __shared__ __attribute__((aligned(16))) unsigned char lds_raw[];
    LAS unsigned char* lds = (LAS unsigned char*)lds_raw;
    cg::grid_group grid = cg::this_grid();
    const int tid = threadIdx.x, lane = tid & 63, wave = __builtin_amdgcn_readfirstlane(tid >> 6);
    const int lo = args.ph_lo, hi = args.ph_hi;
    unsigned char* ws = args.ws;
    const int gw = blockIdx.x * 8 + wave, NGW = gridDim.x * 8;
    float* mod = (float*)(ws + WS_MOD);
#define IN(k) (lo <= (k) && (k) < hi)
    volatile LAS unsigned* bst = (volatile LAS unsigned*)(lds + LDS_BYTES - 64);
    if (tid < 2) bst[tid] = 0u;
    __syncthreads();
    XcdBarrier xbar = xcd_barrier_post((unsigned*)(ws + WS_BAR), bst);
    if (args.dup == 0x7fffffff) grid.sync();
#define SEAM(k) do { if (IN(k) && IN((k) + 1)) xcd_barrier(xbar); } while (0)
#define REP(bit) for (int rep_ = ((MK_DUP >> (bit)) & 1) ? 0 : 1; rep_ < 2; ++rep_)
#define DRY (rep_ == 0 && args.dup != 0)
    if (IN(0)) REP(0) { for (int it = blockIdx.x; it < 96; it += gridDim.x) p0_mod(args, (LAS float*)lds, tid, wave, lane, it); }
    SEAM(0);
    if (IN(1)) REP(1) {
        bf16* H = (bf16*)(ws + WS_H);
        for (int row = gw; row < MA; row += 2 * NGW) { const int r1 = row + NGW; const bool two = r1 < MA;
            const int b0 = row < ML ? (row >> 12) : 8, b1 = two ? (r1 < ML ? (r1 >> 12) : 8) : b0;
            const float* x0 = row < ML ? args.in[0] + (size_t)row * 1024 : args.in[2] + (size_t)(row - ML) * 1024;
            const float* x1 = two ? (r1 < ML ? args.in[0] + (size_t)r1 * 1024 : args.in[2] + (size_t)(r1 - ML) * 1024) : nullptr;
            rownorm_mod2(x0, x1, args.in[6], mod + b0 * 6144, mod + b0 * 6144 + 1024, mod + b1 * 6144, mod + b1 * 6144 + 1024, H + (size_t)row * 1024, H + (size_t)r1 * 1024, lane); }
        p0_transposes(args, lds, tid, wave, lane);
    }
    SEAM(1);
    if (IN(2)) run_inproj(lds, args);
    SEAM(2);
    if (IN(3)) {
        if ((MK_DUP >> 3) & 1) { run_gemm(lds, args, -args.dup, (const bf16*)(ws + WS_Z) + ZQ, ZW, (const bf16*)(ws + WS_WUQ), ML, 768, 384);
            run_gemm(lds, args, -args.dup, (const bf16*)(ws + WS_Z) + ZKV, ZW, (const bf16*)(ws + WS_WUKV), MA, 1024, 256); ropek_phase(args, tid); }
        run_gemm(lds, args, 2, (const bf16*)(ws + WS_Z) + ZQ, ZW, (const bf16*)(ws + WS_WUQ), ML, 768, 384);
        run_gemm(lds, args, 3, (const bf16*)(ws + WS_Z) + ZKV, ZW, (const bf16*)(ws + WS_WUKV), MA, 1024, 256);
        ropek_phase(args, tid);
        bias2_phase(args, wave, lane);
        REP(4) for (int u = (int)gridDim.x - 1 - (int)blockIdx.x; u < 2176; u += gridDim.x) gla_a_unit(args, lds, u, tid, wave, lane);
    }
    SEAM(3);
    if (IN(4)) {
        REP(5) gla_scan(args, tid, DRY);
        const int G_ = (int)gridDim.x, vcu_ = (G_ % 8 == 0) ? ((int)blockIdx.x % 8) * (G_ / 8) + (int)blockIdx.x / 8 : (int)blockIdx.x;
        REP(6) for (int u = vcu_; u < 1024; u += G_) attn_unit(args, lds, u, tid, wave, lane, DRY);
    }
    SEAM(4);
    if (IN(5)) {
        REP(7) for (int u = blockIdx.x; u < 2048; u += gridDim.x) gla_c_unit(args, lds, u, tid, wave, lane);
        { if ((MK_DUP >> 8) & 1) run_gemm(lds, args, -args.dup, (const bf16*)(ws + WS_QN), 512, (const bf16*)(ws + WS_WBRM), ML, 1024, 512); run_gemm(lds, args, 4, (const bf16*)(ws + WS_QN), 512, (const bf16*)(ws + WS_WBRM), ML, 1024, 512); }
    }
    SEAM(5);
    if (IN(6)) { if ((MK_DUP >> 9) & 1) run_gemm(lds, args, -args.dup, (const bf16*)(ws + WS_Y), 512, (const bf16*)(ws + WS_WBRG), ML, 1024, 512); run_gemm(lds, args, 5, (const bf16*)(ws + WS_Y), 512, (const bf16*)(ws + WS_WBRG), ML, 1024, 512); }
    SEAM(6);
    if (IN(7)) { if ((MK_DUP >> 10) & 1) run_gemm(lds, args, -args.dup, (const bf16*)(ws + WS_T1), 1024, (const bf16*)(ws + WS_WOUT), ML, 1024, 1024); run_gemm(lds, args, 6, (const bf16*)(ws + WS_T1), 1024, (const bf16*)(ws + WS_WOUT), ML, 1024, 1024); }
    SEAM(7);
    if (IN(9)) { if ((MK_DUP >> 12) & 1) run_gemm(lds, args, 1, (const bf16*)(ws + WS_H), 1024, (const bf16*)(ws + WS_WUP), ML, FF2, 1024); run_gemm(lds, args, 1, (const bf16*)(ws + WS_H), 1024, (const bf16*)(ws + WS_WUP), ML, FF2, 1024); }
    SEAM(9);
    if (IN(10)) REP(13) conv_phase(args, tid, DRY);
    SEAM(10);
    if (IN(11)) { if ((MK_DUP >> 14) & 1) run_gemm(lds, args, -args.dup, (const bf16*)(ws + WS_Z), FF2, (const bf16*)(ws + WS_WDOWN), ML, 1024, FF); run_gemm(lds, args, 7, (const bf16*)(ws + WS_Z), FF2, (const bf16*)(ws + WS_WDOWN), ML, 1024, FF); }
    if ((MK_DUP >> 16) & 1) { for (int i = 0; i < 10; ++i) xcd_barrier(xbar); }
    SEAM(11);
    if (IN(12)) {
        const float* fg = args.in[23]; const bf16* X2 = (const bf16*)(ws + WS_H);
        for (int row = gw; row < ML; row += 2 * NGW) { const int r1 = (row + NGW < ML) ? row + NGW : row;
            const v4u* p0 = (const v4u*)(X2 + (size_t)row * 1024) + lane; const v4u* p1 = (const v4u*)(X2 + (size_t)r1 * 1024) + lane;
            const v4u a0 = p0[0], a1 = p0[64], b0 = p1[0], b1 = p1[64];
            f32x4 v0[4] = {{lo16(a0.x), hi16(a0.x), lo16(a0.y), hi16(a0.y)}, {lo16(a0.z), hi16(a0.z), lo16(a0.w), hi16(a0.w)}, {lo16(a1.x), hi16(a1.x), lo16(a1.y), hi16(a1.y)}, {lo16(a1.z), hi16(a1.z), lo16(a1.w), hi16(a1.w)}};
            f32x4 v1[4] = {{lo16(b0.x), hi16(b0.x), lo16(b0.y), hi16(b0.y)}, {lo16(b0.z), hi16(b0.z), lo16(b0.w), hi16(b0.w)}, {lo16(b1.x), hi16(b1.x), lo16(b1.y), hi16(b1.y)}, {lo16(b1.z), hi16(b1.z), lo16(b1.w), hi16(b1.w)}};
            float s0 = 0.f, s1 = 0.f;
#pragma unroll
            for (int j = 0; j < 4; ++j) { s0 += (v0[j].x * v0[j].x + v0[j].y * v0[j].y) + (v0[j].z * v0[j].z + v0[j].w * v0[j].w); s1 += (v1[j].x * v1[j].x + v1[j].y * v1[j].y) + (v1[j].z * v1[j].z + v1[j].w * v1[j].w); }
#pragma unroll
            for (int o = 1; o < 64; o <<= 1) { s0 += __shfl_xor(s0, o); s1 += __shfl_xor(s1, o); }
            const float q0 = __builtin_amdgcn_rsqf(s0 * (1.f / 1024.f) + EPS), q1 = __builtin_amdgcn_rsqf(s1 * (1.f / 1024.f) + EPS);
            f32x4* o0 = (f32x4*)(args.out + (size_t)row * 1024); f32x4* o1 = (f32x4*)(args.out + (size_t)r1 * 1024);
#pragma unroll
            for (int j = 0; j < 4; ++j) { const int e4 = (j >> 1) * 128 + 2 * lane + (j & 1);
                const f32x4 gg = ((const f32x4*)fg)[e4]; o0[e4] = v0[j] * q0 * gg; if (r1 != row) o1[e4] = v1[j] * q1 * gg; } }
    }
#undef REP
#undef DRY
#undef IN
#undef SEAM
}

#ifndef MK_SPLIT
#define MK_SPLIT 0
#endif
extern "C" void kernel_launch(void* const* d_in, const int* in_sizes, int n_in, void* d_out, int out_size, void* d_ws, size_t ws_size, hipStream_t stream) {
    static int grid = 0;
    if (grid == 0) {
        if (n_in != 24 || out_size != ML * DM || ws_size < WS_END) { fprintf(stderr, "kernel_launch: unexpected shapes (n_in %d out %d ws %zu)\n", n_in, out_size, ws_size); grid = -1; return; }
        int dev = 0, cus = 0, per_cu = 0;
        hipGetDevice(&dev); hipDeviceGetAttribute(&cus, hipDeviceAttributeMultiprocessorCount, dev);
        if (hipFuncSetAttribute((const void*)mk_fwd, hipFuncAttributeMaxDynamicSharedMemorySize, LDS_BYTES) != hipSuccess) { fprintf(stderr, "kernel_launch: hipFuncSetAttribute failed\n"); grid = -1; return; }
        if (hipOccupancyMaxActiveBlocksPerMultiprocessor(&per_cu, (const void*)mk_fwd, 512, LDS_BYTES) != hipSuccess || per_cu < 1) { fprintf(stderr, "kernel_launch: occupancy query says %d\n", per_cu); per_cu = 1; }
        (void)hipGetLastError();
        grid = cus * 1;
        fprintf(stderr, "kernel_launch: grid %d (cus %d per_cu %d)\n", grid, cus, per_cu);
    }
    if (grid < 0) return;
    hipMemsetAsync((char*)d_ws, 0, WS_ZERO_BYTES, stream);
    Args a{};
    for (int i = 0; i < 24; ++i) a.in[i] = (const float*)d_in[i];
    a.out = (float*)d_out; a.ws = (unsigned char*)d_ws;
#if MK_SPLIT
    for (int ph = 0; ph < NPHASE; ++ph) { a.ph_lo = ph; a.ph_hi = ph + 1; void* kargs[] = {&a};
        hipError_t e = hipLaunchCooperativeKernel((const void*)mk_fwd, dim3(grid), dim3(512), kargs, LDS_BYTES, stream);
        if (e != hipSuccess) { fprintf(stderr, "cooperative launch failed (phase %d): %s\n", ph, hipGetErrorString(e)); break; } }
#else
    a.ph_lo = 0; a.ph_hi = NPHASE; a.dup = 1; void* kargs[] = {&a};
    hipError_t e = hipLaunchCooperativeKernel((const void*)mk_fwd, dim3(grid), dim3(512), kargs, LDS_BYTES, stream);
    if (e != hipSuccess) fprintf(stderr, "cooperative launch failed: %s (grid %d)\n", hipGetErrorString(e), grid);
#endif
}
```
